# Optimizing an MI355X kernel written in HIP

```python
import math
import jax, jax.numpy as jnp
from jax import lax
import numpy as np

D_MODEL = 1024
BATCH = 8
SEQ = 4096
DEPTH = 4

D_FF = 2816
HEAD_DIM = 64
Q_BLOCK = 128
N_DIFF_HEADS = (D_MODEL // 2) // (2 * HEAD_DIM)
N_FOX_HEADS = (D_MODEL // 2) // HEAD_DIM
DIFF_V_DIM = 2 * HEAD_DIM
N_REL_BUCKETS = 32
REL_MAX_DIST = 128
S5_GROUP = 16
S5_GROUPS = D_MODEL // S5_GROUP
S5_STATE = 64
NORM_EPS = 1e-6
N_ATTN_LAYERS = (DEPTH + 1) // 2
N_SSM_LAYERS = DEPTH // 2

DIFF_QK_COLS = N_DIFF_HEADS * 2 * HEAD_DIM
DIFF_V_COLS = N_DIFF_HEADS * DIFF_V_DIM
FOX_COLS = N_FOX_HEADS * HEAD_DIM
IN_SPLITS = (DIFF_QK_COLS, DIFF_QK_COLS, DIFF_V_COLS, FOX_COLS, FOX_COLS, FOX_COLS, N_FOX_HEADS)
IN_COLS = sum(IN_SPLITS)
MIX_COLS = DIFF_V_COLS + FOX_COLS

kernel_name = "hybrid_diff_fox_s5_macaron"


def rmsnorm(x, g):
    xf = x.astype(jnp.float32)
    y = xf * lax.rsqrt(jnp.mean(xf * xf, axis=-1, keepdims=True) + NORM_EPS)
    return (y * g.astype(jnp.float32)).astype(x.dtype)


def swiglu(h, w_gate, w_up, w_down):
    return (jax.nn.silu(h @ w_gate) * (h @ w_up)) @ w_down


def rel_bucket(q_pos, k_pos):
    n = jnp.maximum(q_pos[:, None] - k_pos[None, :], 0)
    max_exact = N_REL_BUCKETS // 2
    nf = jnp.maximum(n, 1).astype(jnp.float32)
    large = max_exact + (jnp.log(nf / max_exact) / math.log(REL_MAX_DIST / max_exact)
                         * (N_REL_BUCKETS - max_exact)).astype(jnp.int32)
    large = jnp.minimum(large, N_REL_BUCKETS - 1)
    return jnp.where(n < max_exact, n, large)


def diff_fox_mixer(h, w_in, w_out, fg_bias, dq_g, dk_g, lq1, lk1, lq2, lk2, subln_g,
                   fq_g, fk_g, rel_bias, layer_idx):
    f32 = jnp.float32
    b, s, _ = h.shape
    proj = h @ w_in
    dq, dk, dv, fq, fk, fv, fl = jnp.split(proj, np.cumsum(IN_SPLITS)[:-1], axis=-1)
    dq = rmsnorm(dq.reshape(b, s, N_DIFF_HEADS, 2, HEAD_DIM), dq_g).transpose(0, 2, 3, 1, 4)
    dk = rmsnorm(dk.reshape(b, s, N_DIFF_HEADS, 2, HEAD_DIM), dk_g).transpose(0, 2, 3, 1, 4)
    dv = dv.reshape(b, s, N_DIFF_HEADS, DIFF_V_DIM).transpose(0, 2, 1, 3)
    fq = rmsnorm(fq.reshape(b, s, N_FOX_HEADS, HEAD_DIM), fq_g).transpose(0, 2, 1, 3)
    fk = rmsnorm(fk.reshape(b, s, N_FOX_HEADS, HEAD_DIM), fk_g).transpose(0, 2, 1, 3)
    fv = fv.reshape(b, s, N_FOX_HEADS, HEAD_DIM).transpose(0, 2, 1, 3)
    log_f = jax.nn.log_sigmoid(fl.astype(f32) + fg_bias.astype(f32))
    cum = jnp.cumsum(log_f, axis=1).transpose(0, 2, 1)

    lam_init = 0.8 - 0.6 * math.exp(-0.3 * layer_idx)
    lam = (jnp.exp(jnp.sum(lq1.astype(f32) * lk1.astype(f32)))
           - jnp.exp(jnp.sum(lq2.astype(f32) * lk2.astype(f32))) + lam_init)
    scale = HEAD_DIM ** -0.5
    pos = jnp.arange(s, dtype=jnp.int32)
    od_blocks, of_blocks = [], []
    for blk in range(s // Q_BLOCK):
        q0, q1 = blk * Q_BLOCK, (blk + 1) * Q_BLOCK
        qpos, kpos = pos[q0:q1], pos[:q1]
        causal = kpos[None, :] <= qpos[:, None]
        bias = rel_bias[rel_bucket(qpos, kpos)].transpose(2, 0, 1).astype(f32)
        lg = (jnp.einsum('bhmqd,bhmkd->bhmqk', dq[:, :, :, q0:q1], dk[:, :, :, :q1]).astype(f32) * scale
              + bias[None, :, None])
        p = jax.nn.softmax(jnp.where(causal, lg, -jnp.inf), axis=-1)
        pd = p[:, :, 0] - lam * p[:, :, 1]
        od_blocks.append(jnp.einsum('bhqk,bhkv->bhqv', pd.astype(dv.dtype), dv[:, :, :q1]))
        lf = (jnp.einsum('bhqd,bhkd->bhqk', fq[:, :, q0:q1], fk[:, :, :q1]).astype(f32) * scale
              + cum[:, :, q0:q1, None] - cum[:, :, None, :q1])
        pf = jax.nn.softmax(jnp.where(causal, lf, -jnp.inf), axis=-1)
        of_blocks.append(jnp.einsum('bhqk,bhkv->bhqv', pf.astype(fv.dtype), fv[:, :, :q1]))
    od = jnp.concatenate(od_blocks, axis=2)
    od = rmsnorm(od, subln_g) * (1.0 - lam_init)
    od = od.transpose(0, 2, 1, 3).reshape(b, s, DIFF_V_COLS)
    of = jnp.concatenate(of_blocks, axis=2).transpose(0, 2, 1, 3).reshape(b, s, FOX_COLS)
    return jnp.concatenate([od, of], axis=-1) @ w_out


def _complex_linear_combine(left, right):
    ar1, ai1, br1, bi1 = left
    ar2, ai2, br2, bi2 = right
    return (ar2 * ar1 - ai2 * ai1,
            ar2 * ai1 + ai2 * ar1,
            ar2 * br1 - ai2 * bi1 + br2,
            ar2 * bi1 + ai2 * br1 + bi2)


def s5_mixer(h, a_re, a_im, log_step, b_re, b_im, c_re, c_im, d_skip, w_glu_a, w_glu_b):
    f32 = jnp.float32
    b, s, _ = h.shape
    u = h.reshape(b, s, S5_GROUPS, S5_GROUP).astype(f32)
    step = jnp.exp(log_step.astype(f32))[:, None]
    ar, ai = a_re.astype(f32), a_im.astype(f32)
    mag = jnp.exp(ar * step)
    lr, li = mag * jnp.cos(ai * step), mag * jnp.sin(ai * step)
    den = ar * ar + ai * ai
    cr = ((lr - 1.0) * ar + li * ai) / den
    ci = (li * ar - (lr - 1.0) * ai) / den
    br, bi = b_re.astype(f32), b_im.astype(f32)
    bbr = cr[..., None] * br - ci[..., None] * bi
    bbi = cr[..., None] * bi + ci[..., None] * br
    xr = jnp.einsum('bsgc,gpc->bsgp', u, bbr)
    xi = jnp.einsum('bsgc,gpc->bsgp', u, bbi)
    lr_s = jnp.broadcast_to(lr, (1, s, S5_GROUPS, S5_STATE))
    li_s = jnp.broadcast_to(li, (1, s, S5_GROUPS, S5_STATE))
    _, _, xr, xi = lax.associative_scan(_complex_linear_combine, (lr_s, li_s, xr, xi), axis=1)
    y = (jnp.einsum('bsgp,gcp->bsgc', xr, c_re.astype(f32))
         - jnp.einsum('bsgp,gcp->bsgc', xi, c_im.astype(f32)))
    y = y.reshape(b, s, D_MODEL) + d_skip.astype(f32) * h.astype(f32)
    y = jax.nn.gelu(y).astype(h.dtype)
    return (y @ w_glu_a) * jax.nn.sigmoid(y @ w_glu_b)


def setup_inputs(seed: int = 0) -> dict:
    key = jax.random.key(seed)
    keys = list(jax.random.split(key, 48))
    it = iter(keys)

    def nrm(shape, scale):
        return jax.random.normal(next(it), shape, jnp.float32) * scale

    def gain(shape):
        return 1.0 + nrm(shape, 0.05)

    L, La, Ls = DEPTH, N_ATTN_LAYERS, N_SSM_LAYERS
    x = nrm((BATCH, SEQ, D_MODEL), 1.0)
    ffn1_norm = gain((L, D_MODEL))
    ffn1_gate = nrm((L, D_MODEL, D_FF), D_MODEL ** -0.5)
    ffn1_up = nrm((L, D_MODEL, D_FF), D_MODEL ** -0.5)
    ffn1_down = nrm((L, D_FF, D_MODEL), D_FF ** -0.5)
    mix_norm = gain((L, D_MODEL))
    ffn2_norm = gain((L, D_MODEL))
    ffn2_gate = nrm((L, D_MODEL, D_FF), D_MODEL ** -0.5)
    ffn2_up = nrm((L, D_MODEL, D_FF), D_MODEL ** -0.5)
    ffn2_down = nrm((L, D_FF, D_MODEL), D_FF ** -0.5)
    attn_w_in = nrm((La, D_MODEL, IN_COLS), D_MODEL ** -0.5)
    attn_w_out = nrm((La, MIX_COLS, D_MODEL), MIX_COLS ** -0.5)
    fg_bias = jax.random.uniform(next(it), (La, N_FOX_HEADS), jnp.float32, 1.0, 5.0)
    diff_q_norm = gain((La, HEAD_DIM))
    diff_k_norm = gain((La, HEAD_DIM))
    diff_lambda_q1 = nrm((La, HEAD_DIM), 0.1)
    diff_lambda_k1 = nrm((La, HEAD_DIM), 0.1)
    diff_lambda_q2 = nrm((La, HEAD_DIM), 0.1)
    diff_lambda_k2 = nrm((La, HEAD_DIM), 0.1)
    diff_subln = gain((La, DIFF_V_DIM))
    fox_q_norm = gain((La, HEAD_DIM))
    fox_k_norm = gain((La, HEAD_DIM))
    rel_bias = nrm((N_REL_BUCKETS, N_DIFF_HEADS), 0.5)
    s5_a_re = -0.5 + nrm((Ls, S5_GROUPS, S5_STATE), 0.01)
    s5_a_im = (math.pi * jnp.arange(S5_STATE, dtype=jnp.float32))[None, None, :] \
        + nrm((Ls, S5_GROUPS, S5_STATE), 0.01)
    s5_log_step = jax.random.uniform(next(it), (Ls, S5_GROUPS), jnp.float32,
                                     math.log(1e-3), math.log(1e-1))
    s5_b_re = nrm((Ls, S5_GROUPS, S5_STATE, S5_GROUP), (2 * S5_GROUP) ** -0.5)
    s5_b_im = nrm((Ls, S5_GROUPS, S5_STATE, S5_GROUP), (2 * S5_GROUP) ** -0.5)
    s5_c_re = nrm((Ls, S5_GROUPS, S5_GROUP, S5_STATE), S5_STATE ** -0.5)
    s5_c_im = nrm((Ls, S5_GROUPS, S5_GROUP, S5_STATE), S5_STATE ** -0.5)
    s5_d = nrm((Ls, D_MODEL), 1.0)
    s5_glu_a = nrm((Ls, D_MODEL, D_MODEL), D_MODEL ** -0.5)
    s5_glu_b = nrm((Ls, D_MODEL, D_MODEL), D_MODEL ** -0.5)
    return {"x": x,
            "ffn1_norm": ffn1_norm, "ffn1_gate": ffn1_gate, "ffn1_up": ffn1_up, "ffn1_down": ffn1_down,
            "mix_norm": mix_norm,
            "ffn2_norm": ffn2_norm, "ffn2_gate": ffn2_gate, "ffn2_up": ffn2_up, "ffn2_down": ffn2_down,
            "attn_w_in": attn_w_in, "attn_w_out": attn_w_out, "fg_bias": fg_bias,
            "diff_q_norm": diff_q_norm, "diff_k_norm": diff_k_norm,
            "diff_lambda_q1": diff_lambda_q1, "diff_lambda_k1": diff_lambda_k1,
            "diff_lambda_q2": diff_lambda_q2, "diff_lambda_k2": diff_lambda_k2,
            "diff_subln": diff_subln, "fox_q_norm": fox_q_norm, "fox_k_norm": fox_k_norm,
            "rel_bias": rel_bias,
            "s5_a_re": s5_a_re, "s5_a_im": s5_a_im, "s5_log_step": s5_log_step,
            "s5_b_re": s5_b_re, "s5_b_im": s5_b_im, "s5_c_re": s5_c_re, "s5_c_im": s5_c_im,
            "s5_d": s5_d, "s5_glu_a": s5_glu_a, "s5_glu_b": s5_glu_b}


def reference(x, ffn1_norm, ffn1_gate, ffn1_up, ffn1_down, mix_norm,
              ffn2_norm, ffn2_gate, ffn2_up, ffn2_down,
              attn_w_in, attn_w_out, fg_bias, diff_q_norm, diff_k_norm,
              diff_lambda_q1, diff_lambda_k1, diff_lambda_q2, diff_lambda_k2,
              diff_subln, fox_q_norm, fox_k_norm, rel_bias,
              s5_a_re, s5_a_im, s5_log_step, s5_b_re, s5_b_im, s5_c_re, s5_c_im,
              s5_d, s5_glu_a, s5_glu_b):
    for i in range(DEPTH):
        x = x + 0.5 * swiglu(rmsnorm(x, ffn1_norm[i]), ffn1_gate[i], ffn1_up[i], ffn1_down[i])
        h = rmsnorm(x, mix_norm[i])
        j = i // 2
        if i % 2 == 0:
            x = x + diff_fox_mixer(h, attn_w_in[j], attn_w_out[j], fg_bias[j],
                                   diff_q_norm[j], diff_k_norm[j],
                                   diff_lambda_q1[j], diff_lambda_k1[j],
                                   diff_lambda_q2[j], diff_lambda_k2[j],
                                   diff_subln[j], fox_q_norm[j], fox_k_norm[j],
                                   rel_bias, i)
        else:
            x = x + s5_mixer(h, s5_a_re[j], s5_a_im[j], s5_log_step[j],
                             s5_b_re[j], s5_b_im[j], s5_c_re[j], s5_c_im[j],
                             s5_d[j], s5_glu_a[j], s5_glu_b[j])
        x = x + 0.5 * swiglu(rmsnorm(x, ffn2_norm[i]), ffn2_gate[i], ffn2_up[i], ffn2_down[i])
    return x
```

```cpp
#include <hip/hip_runtime.h>
#include <hip/hip_cooperative_groups.h>
#include <cstdio>
#include <cstdint>
#include <cmath>
namespace cg = cooperative_groups;

#define LAS __attribute__((address_space(3)))
typedef unsigned short bf16_t;
typedef short bf16x8 __attribute__((ext_vector_type(8)));
typedef short s16x4 __attribute__((ext_vector_type(4)));
typedef float f32x4 __attribute__((ext_vector_type(4)));
typedef float f32x16 __attribute__((ext_vector_type(16)));
typedef unsigned u32x4 __attribute__((ext_vector_type(4)));
typedef unsigned u32x2 __attribute__((ext_vector_type(2)));

constexpr int MTOK = 32768, DM = 1024, FF = 2816, SEQ = 4096, NB = 8;
constexpr float EPS = 1e-6f;
constexpr float LOG2E = 1.4426950408889634f;
constexpr float QSCALE = 0.125f * LOG2E;

constexpr size_t MiB = 1u << 20;
constexpr size_t WS_CTL = 0;
constexpr size_t WS_SS = 1 * MiB;
constexpr size_t WS_LF = 5 * MiB;
constexpr size_t WS_CUM = 6 * MiB;
constexpr size_t WS_WGU = 8 * MiB;
constexpr size_t WGU_SZ = (size_t)5632 * 1024 * 2;
constexpr size_t WS_WDN = 96 * MiB;
constexpr size_t WDN_SZ = (size_t)1024 * 2816 * 2;
constexpr size_t WS_WIN = 140 * MiB;
constexpr size_t WIN_SZ = (size_t)3328 * 1024 * 2;
constexpr size_t WS_WOUT = 153 * MiB;
constexpr size_t WOUT_SZ = (size_t)1024 * 1024 * 2;
constexpr size_t WS_WGLU = 157 * MiB;
constexpr size_t WGLU_SZ = (size_t)2048 * 1024 * 2;
constexpr size_t WS_S5W1 = 165 * MiB;
constexpr size_t WS_S5WA = 181 * MiB;
constexpr size_t WS_XB = 221 * MiB;
constexpr size_t WS_R = 285 * MiB;
constexpr size_t WS_END = 477 * MiB;
constexpr size_t R_H = 0;
constexpr size_t R_Q = 0, R_K = 64 * MiB, R_V = 128 * MiB;
constexpr size_t R_UA = 0;
constexpr size_t R_SST = 80 * MiB;
constexpr size_t R_Y = 112 * MiB;

constexpr int LDS_BYTES = 147456;
constexpr int LDS_RS = 131072;
constexpr int LDS_GT = 131072 + 12288;

__device__ __forceinline__ unsigned cvt_pk_bf16(float lo, float hi) { unsigned r; asm volatile("v_cvt_pk_bf16_f32 %0, %1, %2" : "=v"(r) : "v"(lo), "v"(hi)); return r; }
__device__ __forceinline__ float bf_lo(unsigned w) { return __uint_as_float(w << 16); }
__device__ __forceinline__ float bf_hi(unsigned w) { return __uint_as_float(w & 0xffff0000u); }
__device__ __forceinline__ float fast_exp2(float x) { return __builtin_amdgcn_exp2f(x); }
__device__ __forceinline__ float fast_rcp(float x) { return __builtin_amdgcn_rcpf(x); }
__device__ __forceinline__ float sigmoidf_(float x) { return fast_rcp(1.0f + fast_exp2(-x * LOG2E)); }
__device__ __forceinline__ float gelu_tanh(float y) { const float z = 1.5957691216057308f * (y + 0.044715f * y * y * y); return y * sigmoidf_(z); }
__device__ __forceinline__ u32x4 pack8(f32x4 a, f32x4 b) { u32x4 w; w.x = cvt_pk_bf16(a[0], a[1]); w.y = cvt_pk_bf16(a[2], a[3]); w.z = cvt_pk_bf16(b[0], b[1]); w.w = cvt_pk_bf16(b[2], b[3]); return w; }

template <int K> __device__ __forceinline__ float swz_xor(float v) { return __int_as_float(__builtin_amdgcn_ds_swizzle(__float_as_int(v), 0x1f | (K << 10))); }
__device__ __forceinline__ float red32_add(float v) { auto rr = __builtin_amdgcn_permlane32_swap(__float_as_uint(v), __float_as_uint(v), false, false); return __uint_as_float(rr[0]) + __uint_as_float(rr[1]); }
__device__ __forceinline__ float red32_max(float v) { auto rr = __builtin_amdgcn_permlane32_swap(__float_as_uint(v), __float_as_uint(v), false, false); return fmaxf(__uint_as_float(rr[0]), __uint_as_float(rr[1])); }
__device__ __forceinline__ float red16_add(float v) { return v + swz_xor<16>(v); }
extern __shared__ __attribute__((aligned(16))) unsigned char lds_raw[];
constexpr int LDS_WIDTAB = 131072 + 12288 + 1024;
__device__ __forceinline__ int opaque_s(int v) { asm volatile("" : "+s"(v)); return v; }
__device__ __forceinline__ int hw_wave_key() { int k; asm volatile("s_getreg_b32 %0, hwreg(HW_REG_HW_ID, 0, 6)" : "=s"(k)); return k & 63; }
__device__ __forceinline__ int opaque_tid() {
    int lane; asm volatile("v_mbcnt_lo_u32_b32 %0, -1, 0\n\tv_mbcnt_hi_u32_b32 %0, -1, %0" : "=v"(lane));
    const int key = hw_wave_key();
    const int wid = __builtin_amdgcn_readfirstlane(*(volatile LAS int*)((LAS unsigned char*)lds_raw + LDS_WIDTAB + key * 4));
    return wid * 64 + lane;
}
namespace pg8 {
constexpr int BM = 256, BK = 64, HALF = 128, HTB = HALF * BK * 2, STAGE_BYTES = 8 * HTB, NXCD = 8, WGM = 8;
__host__ __device__ __forceinline__ int lds_byte(int r, int c) { const int st = (r >> 4) * 2 + (c >> 5), rr = r & 15, cc = c & 31, ob = rr * 64 + cc * 2; return st * 1024 + (ob ^ (((ob >> 9) & 1) << 5)); }
__host__ __device__ __forceinline__ void stage_rc(int b, int& R, int& C) { const int st = b / 1024, sb = b % 1024, swz = sb ^ (((sb >> 9) & 1) << 5); R = (st >> 1) * 16 + swz / 64; C = (st & 1) * 32 + (swz % 64) / 2; }
__host__ __device__ __forceinline__ int perm32(int rho) { const int n = rho >> 4, i = rho & 15; return 8 * (i >> 2) + 4 * n + (i & 3); }

struct Unit { int pm, pn; };
struct Gemm { const bf16_t* A; const bf16_t* Bt; int lda, ldb, K; };

struct StaticOrder {
    int nM, nN, nwg, G, c;
    __device__ void init(int M, int N, int G_, int c_) { nM = M / BM; nN = N / BM; nwg = nM * nN; G = G_; c = c_; }
    __device__ bool next(int i, Unit& u) const {
        const long L = (long)i * G + c; if (L >= nwg) return false;
        int wgid = (int)L; { const int q = nwg / NXCD, r = nwg % NXCD, xcd = wgid % NXCD, off = wgid / NXCD; wgid = (xcd < r ? xcd * (q + 1) : r * (q + 1) + (xcd - r) * q) + off; }
        const int nig = WGM * nN, gid = wgid / nig, fm = gid * WGM, gsz = (nM - fm) < WGM ? (nM - fm) : WGM;
        u.pm = fm + ((wgid % nig) % gsz); u.pn = (wgid % nig) / gsz; return true;
    }
};
struct S5StateOrder {
    int G, c;
    __device__ bool next(int i, Unit& u) const { const int L = i * G + c; if (L >= 256) return false; u.pm = L; u.pn = L >> 2; return true; }
};
struct S5OutOrder {
    int G, c;
    __device__ bool next(int i, Unit& u) const { const int L = i * G + c; if (L >= 512) return false; const int g = L >> 3, r = L & 7; u.pm = 4 * g + (r >> 1); u.pn = 2 * g + (r & 1); return true; }
};

template <class Epi, class Sched>
__device__ __forceinline__ void gemm_phase(LAS unsigned char* lds, const Gemm g, const Sched& S, const Epi& E) {
    const int tid = opaque_tid(), wid = __builtin_amdgcn_readfirstlane(tid >> 6), lane = tid & 63, wr = wid >> 2, wc = wid & 3, fr = lane & 15, fq = lane >> 4;
    const int K = g.K, nt = K / BK;
    unsigned voffA[2], voffB[2];
#pragma unroll
    for (int i = 0; i < 2; ++i) { int R, C; stage_rc(tid * 16 + i * 8192, R, C); const int Rb = Epi::PERM ? ((R & ~31) + perm32(R & 31)) : R;
        voffA[i] = (unsigned)(R * g.lda + C) * 2u; voffB[i] = (unsigned)(Rb * g.ldb + C) * 2u; }
    const size_t kstep = (size_t)(BK * 2);
    const size_t hA = (size_t)HALF * g.lda * 2, hB = (size_t)HALF * g.ldb * 2;
    const size_t tA = 2 * hA, tB = 2 * hB;
    const unsigned ldsw = (unsigned)wid * 1024u;
    const int aoff = lds_byte(wr * 64 + fr, fq * 8), boff = lds_byte(wc * 32 + fr, fq * 8);
#define PG8_SA(b, h) (((b) * 2 + (h)) * HTB)
#define PG8_SB(b, h) ((4 + (b) * 2 + (h)) * HTB)
#define PG8_STAGE(bufoff, gbase, voff) do { _Pragma("unroll") for (int _i = 0; _i < 2; ++_i) \
        __builtin_amdgcn_global_load_lds((const unsigned*)((const char*)(gbase) + (voff)[_i]), (LAS unsigned*)(lds + (bufoff) + ldsw + _i * 8192), 16, 0, 0); } while (0)
#define PG8_LDA(dst, b, h) do { _Pragma("unroll") for (int m = 0; m < 4; ++m) _Pragma("unroll") for (int k = 0; k < 2; ++k) dst[m][k] = *(const LAS bf16x8*)(lds + PG8_SA(b, h) + aoff + m * 2048 + k * 1024); } while (0)
#define PG8_LDB(dst, b, h) do { _Pragma("unroll") for (int n = 0; n < 2; ++n) _Pragma("unroll") for (int k = 0; k < 2; ++k) dst[n][k] = *(const LAS bf16x8*)(lds + PG8_SB(b, h) + boff + n * 2048 + k * 1024); } while (0)
#define PG8_MMA(ai, bj, At, Bt) do { __builtin_amdgcn_s_setprio(1); _Pragma("unroll") for (int m = 0; m < 4; ++m) _Pragma("unroll") for (int n = 0; n < 2; ++n) _Pragma("unroll") for (int k = 0; k < 2; ++k) \
        acc[ai][bj][m][n] = __builtin_amdgcn_mfma_f32_16x16x32_bf16(Bt[n][k], At[m][k], acc[ai][bj][m][n], 0, 0, 0); __builtin_amdgcn_s_setprio(0); } while (0)
#define PG8_WAIT_V(n) asm volatile("s_waitcnt vmcnt(" #n ")" ::: "memory")
#define PG8_WAIT_L(n) asm volatile("s_waitcnt lgkmcnt(" #n ")" ::: "memory")
#define PG8_BAR __builtin_amdgcn_s_barrier()
#define PG8_SCHED __builtin_amdgcn_sched_barrier(0)
    Unit cur, nxt; int ui = 0;
    if (!S.next(0, cur)) return;
    f32x4 acc[2][2][4][2];
#pragma unroll
    for (int a = 0; a < 2; ++a)
#pragma unroll
        for (int b = 0; b < 2; ++b)
#pragma unroll
            for (int m = 0; m < 4; ++m)
#pragma unroll
                for (int n = 0; n < 2; ++n) acc[a][b][m][n] = (f32x4){0.f, 0.f, 0.f, 0.f};
    bf16x8 At[4][2], B0[2][2], B1[2][2];
    const char* cA = (const char*)g.A + (size_t)cur.pm * tA; const char* cB = (const char*)g.Bt + (size_t)cur.pn * tB;
    PG8_STAGE(PG8_SB(0, 0), cB, voffB); PG8_STAGE(PG8_SB(0, 1), cB + hB, voffB); PG8_STAGE(PG8_SA(0, 0), cA, voffA); PG8_STAGE(PG8_SA(0, 1), cA + hA, voffA);
    if (wr == 1) PG8_BAR;
    PG8_WAIT_V(2); PG8_BAR;
    PG8_STAGE(PG8_SB(1, 0), cB + kstep, voffB); PG8_STAGE(PG8_SA(1, 0), cA + kstep, voffA); PG8_STAGE(PG8_SB(1, 1), cB + hB + kstep, voffB);
    PG8_WAIT_V(6); PG8_BAR;
    for (;;) {
        const bool has_next = S.next(ui + 1, nxt);
        const char* nA = has_next ? (const char*)g.A + (size_t)nxt.pm * tA : cA; const char* nB = has_next ? (const char*)g.Bt + (size_t)nxt.pn * tB : cB;
        for (int t = 0; t < nt; t += 2) {
            const bool last = (t == nt - 2);
            const char* a1 = cA + (size_t)(t + 1) * kstep;
            const char* a2 = last ? nA : cA + (size_t)(t + 2) * kstep; const char* b2 = last ? nB : cB + (size_t)(t + 2) * kstep;
            const char* a3 = a2 + kstep; const char* b3 = b2 + kstep;
            PG8_LDB(B0, 0, 0); PG8_LDB(B1, 0, 1); PG8_SCHED; PG8_LDA(At, 0, 0); PG8_STAGE(PG8_SA(1, 1), a1 + hA, voffA);
            PG8_WAIT_V(8); PG8_WAIT_L(0); PG8_BAR; PG8_MMA(0, 0, At, B0); PG8_MMA(0, 1, At, B1); PG8_BAR; PG8_SCHED;
            PG8_LDA(At, 0, 1); PG8_STAGE(PG8_SB(0, 0), b2, voffB); PG8_STAGE(PG8_SB(0, 1), b2 + hB, voffB); PG8_STAGE(PG8_SA(0, 0), a2, voffA);
            PG8_WAIT_V(8); PG8_WAIT_L(0); PG8_BAR; PG8_MMA(1, 0, At, B0); PG8_MMA(1, 1, At, B1); PG8_BAR; PG8_SCHED;
            PG8_LDB(B0, 1, 0); PG8_LDB(B1, 1, 1); PG8_SCHED; PG8_LDA(At, 1, 0); PG8_STAGE(PG8_SA(0, 1), a2 + hA, voffA);
            PG8_WAIT_V(8); PG8_WAIT_L(0); PG8_BAR; PG8_MMA(0, 0, At, B0); PG8_MMA(0, 1, At, B1); PG8_BAR; PG8_SCHED;
            PG8_LDA(At, 1, 1); PG8_STAGE(PG8_SB(1, 0), b3, voffB); PG8_STAGE(PG8_SB(1, 1), b3 + hB, voffB); PG8_STAGE(PG8_SA(1, 0), a3, voffA);
            PG8_WAIT_V(8); PG8_WAIT_L(0); PG8_BAR; PG8_MMA(1, 0, At, B0); PG8_MMA(1, 1, At, B1); PG8_BAR; PG8_SCHED;
        }
        if (wr == 0) PG8_BAR;
        E(acc, cur, ui, wr, wc, fr, fq);
        if (!has_next) break;
#pragma unroll
        for (int a = 0; a < 2; ++a)
#pragma unroll
            for (int b = 0; b < 2; ++b)
#pragma unroll
                for (int m = 0; m < 4; ++m)
#pragma unroll
                    for (int n = 0; n < 2; ++n) acc[a][b][m][n] = (f32x4){0.f, 0.f, 0.f, 0.f};
        cur = nxt; cA = nA; cB = nB; ++ui;
        if (wr == 1) PG8_BAR;
    }
    PG8_WAIT_V(0);
    PG8_BAR;
#undef PG8_SA
#undef PG8_SB
#undef PG8_STAGE
#undef PG8_LDA
#undef PG8_LDB
#undef PG8_MMA
#undef PG8_WAIT_V
#undef PG8_WAIT_L
#undef PG8_BAR
#undef PG8_SCHED
}

typedef f32x4 AccT[2][2][4][2];

struct EpiGateUp {
    static constexpr bool PERM = true;
    bf16_t* H; const LAS float* rs;
    __device__ __forceinline__ void operator()(const AccT& acc, const Unit& u, int ui, int wr, int wc, int fr, int fq) const {
        const int col0 = u.pn * 128 + wc * 32 + 8 * fq;
#pragma unroll
        for (int ai = 0; ai < 2; ++ai)
#pragma unroll
            for (int m = 0; m < 4; ++m) {
                const int rt = ai * 128 + wr * 64 + m * 16 + fr; const float r = rs[ui * 256 + rt];
                f32x4 hv[2];
#pragma unroll
                for (int n = 0; n < 2; ++n) { const f32x4 gv = acc[ai][0][m][n] * r, uv = acc[ai][1][m][n] * r;
#pragma unroll
                    for (int i = 0; i < 4; ++i) hv[n][i] = gv[i] * sigmoidf_(gv[i]) * uv[i]; }
                *(u32x4*)(H + (size_t)(u.pm * 256 + rt) * FF + col0) = pack8(hv[0], hv[1]);
            }
    }
};
struct EpiResAdd {
    static constexpr bool PERM = true;
    float* X; bf16_t* XB; float* SS; float scale;
    __device__ __forceinline__ void operator()(const AccT& acc, const Unit& u, int ui, int wr, int wc, int fr, int fq) const {
        const int col0 = u.pn * 256 + wc * 32 + 8 * fq;
#pragma unroll
        for (int ai = 0; ai < 2; ++ai)
#pragma unroll
            for (int m = 0; m < 4; ++m) {
                const size_t row = (size_t)u.pm * 256 + ai * 128 + wr * 64 + m * 16 + fr;
#pragma unroll
                for (int bj = 0; bj < 2; ++bj) {
                    float* xp = X + row * DM + col0 + bj * 128;
                    f32x4 a = *(const f32x4*)xp, b = *(const f32x4*)(xp + 4);
                    a = a + acc[ai][bj][m][0] * scale; b = b + acc[ai][bj][m][1] * scale;
                    *(f32x4*)xp = a; *(f32x4*)(xp + 4) = b;
                    *(u32x4*)(XB + row * DM + col0 + bj * 128) = pack8(a, b);
                    float ss = (a[0] * a[0] + a[1] * a[1]) + (a[2] * a[2] + a[3] * a[3]) + (b[0] * b[0] + b[1] * b[1]) + (b[2] * b[2] + b[3] * b[3]);
                    ss = red16_add(ss); ss = red32_add(ss);
                    if (fq == 0) SS[row * 32 + u.pn * 8 + bj * 4 + wc] = ss;
                }
            }
    }
};
struct EpiGlu {
    static constexpr bool PERM = true;
    float* X; bf16_t* XB; float* SS;
    __device__ __forceinline__ void operator()(const AccT& acc, const Unit& u, int ui, int wr, int wc, int fr, int fq) const {
        const int col0 = u.pn * 128 + wc * 32 + 8 * fq;
#pragma unroll
        for (int ai = 0; ai < 2; ++ai)
#pragma unroll
            for (int m = 0; m < 4; ++m) {
                const size_t row = (size_t)u.pm * 256 + ai * 128 + wr * 64 + m * 16 + fr;
                float* xp = X + row * DM + col0;
                f32x4 a = *(const f32x4*)xp, b = *(const f32x4*)(xp + 4);
#pragma unroll
                for (int i = 0; i < 4; ++i) { a[i] += acc[ai][0][m][0][i] * sigmoidf_(acc[ai][1][m][0][i]); b[i] += acc[ai][0][m][1][i] * sigmoidf_(acc[ai][1][m][1][i]); }
                *(f32x4*)xp = a; *(f32x4*)(xp + 4) = b;
                *(u32x4*)(XB + row * DM + col0) = pack8(a, b);
                float ss = (a[0] * a[0] + a[1] * a[1]) + (a[2] * a[2] + a[3] * a[3]) + (b[0] * b[0] + b[1] * b[1]) + (b[2] * b[2] + b[3] * b[3]);
                ss = red16_add(ss); ss = red32_add(ss);
                if (fq == 0) SS[row * 32 + u.pn * 4 + wc] = ss;
            }
    }
};
struct EpiInProj {
    static constexpr bool PERM = true;
    bf16_t* QKV; float* LF; const LAS float* rs; const LAS float* gt; const float* fgb;
    __device__ __forceinline__ void operator()(const AccT& acc, const Unit& u, int ui, int wr, int wc, int fr, int fq) const {
        if (u.pn == 12) {
            if (wc == 0 && fq == 0) {
                const f32x4 b0 = *(const f32x4*)fgb, b1 = *(const f32x4*)(fgb + 4);
#pragma unroll
                for (int ai = 0; ai < 2; ++ai)
#pragma unroll
                    for (int m = 0; m < 4; ++m) {
                        const int rt = ai * 128 + wr * 64 + m * 16 + fr; const float r = rs[ui * 256 + rt];
                        f32x4 z0 = acc[ai][0][m][0] * r + b0, z1 = acc[ai][0][m][1] * r + b1;
#pragma unroll
                        for (int i = 0; i < 4; ++i) { z0[i] = fminf(z0[i], 0.f) - log1pf(__expf(-fabsf(z0[i]))); z1[i] = fminf(z1[i], 0.f) - log1pf(__expf(-fabsf(z1[i]))); }
                        float* lp = LF + (size_t)(u.pm * 256 + rt) * 8; *(f32x4*)lp = z0; *(f32x4*)(lp + 4) = z1;
                    }
            }
            return;
        }
        const int sl = 4 * u.pn + wc, region = sl >> 3, within = sl & 7, kind = region % 3;
        const int colbase = (region >= 3 ? 512 : 0) + within * 64 + 8 * fq;
        bf16_t* dst = QKV + (size_t)kind * ((size_t)MTOK * DM);
        const int gsel = (region >= 3 ? 2 : 0) + (kind == 1 ? 1 : 0);
        f32x4 gn[2][2];
#pragma unroll
        for (int bj = 0; bj < 2; ++bj)
#pragma unroll
            for (int n = 0; n < 2; ++n) gn[bj][n] = *(const LAS f32x4*)(gt + gsel * 64 + 32 * bj + 8 * fq + 4 * n);
        const bool isv = (kind == 2);
        const float qs = kind == 0 ? QSCALE : 1.0f;
#pragma unroll
        for (int ai = 0; ai < 2; ++ai)
#pragma unroll
            for (int m = 0; m < 4; ++m) {
                const int rt = ai * 128 + wr * 64 + m * 16 + fr; const float r = rs[ui * 256 + rt];
                f32x4 v[2][2]; float ss = 0.f;
#pragma unroll
                for (int bj = 0; bj < 2; ++bj)
#pragma unroll
                    for (int n = 0; n < 2; ++n) { v[bj][n] = acc[ai][bj][m][n] * r; const f32x4 x = v[bj][n]; ss += (x[0] * x[0] + x[1] * x[1]) + (x[2] * x[2] + x[3] * x[3]); }
                ss = red16_add(ss); ss = red32_add(ss);
                const float rn = isv ? 1.0f : rsqrtf(ss * (1.0f / 64.0f) + EPS) * qs;
                bf16_t* rowp = dst + (size_t)(u.pm * 256 + rt) * DM + colbase;
#pragma unroll
                for (int bj = 0; bj < 2; ++bj) { f32x4 x0 = v[bj][0] * rn, x1 = v[bj][1] * rn; if (!isv) { x0 = x0 * gn[bj][0]; x1 = x1 * gn[bj][1]; } *(u32x4*)(rowp + 32 * bj) = pack8(x0, x1); }
            }
    }
};
struct EpiS5State {
    static constexpr bool PERM = true;
    float* SST;
    __device__ __forceinline__ void operator()(const AccT& acc, const Unit& u, int ui, int wr, int wc, int fr, int fq) const {
#pragma unroll
        for (int ai = 0; ai < 2; ++ai)
#pragma unroll
            for (int m = 0; m < 4; ++m) {
                const size_t row = (size_t)u.pm * 256 + ai * 128 + wr * 64 + m * 16 + fr;
                float* p = SST + row * 128 + wc * 32 + 8 * fq;
                *(f32x4*)p = acc[ai][0][m][0]; *(f32x4*)(p + 4) = acc[ai][0][m][1];
            }
    }
};
struct EpiS5Out {
    static constexpr bool PERM = true;
    const bf16_t* UA; const float* dsk; bf16_t* Y;
    __device__ __forceinline__ void operator()(const AccT& acc, const Unit& u, int ui, int wr, int wc, int fr, int fq) const {
        const int g = u.pm >> 2;
#pragma unroll
        for (int ai = 0; ai < 2; ++ai)
#pragma unroll
            for (int m = 0; m < 4; ++m) {
                const int row = u.pm * 256 + ai * 128 + wr * 64 + m * 16 + fr;
                const int n_ = row & 1023, b = n_ >> 7, k = n_ & 127;
#pragma unroll
                for (int bj = 0; bj < 2; ++bj) {
                    const int col8 = (u.pn & 1) * 256 + bj * 128 + wc * 32 + 8 * fq, t = col8 >> 4, c0 = col8 & 15;
                    const u32x4 uw = *(const u32x4*)(UA + (size_t)row * 640 + col8);
                    const f32x4 d0 = *(const f32x4*)(dsk + g * 16 + c0), d1 = *(const f32x4*)(dsk + g * 16 + c0 + 4);
                    f32x4 y0, y1;
                    y0[0] = acc[ai][bj][m][0][0] + d0[0] * bf_lo(uw.x); y0[1] = acc[ai][bj][m][0][1] + d0[1] * bf_hi(uw.x);
                    y0[2] = acc[ai][bj][m][0][2] + d0[2] * bf_lo(uw.y); y0[3] = acc[ai][bj][m][0][3] + d0[3] * bf_hi(uw.y);
                    y1[0] = acc[ai][bj][m][1][0] + d1[0] * bf_lo(uw.z); y1[1] = acc[ai][bj][m][1][1] + d1[1] * bf_hi(uw.z);
                    y1[2] = acc[ai][bj][m][1][2] + d1[2] * bf_lo(uw.w); y1[3] = acc[ai][bj][m][1][3] + d1[3] * bf_hi(uw.w);
#pragma unroll
                    for (int i = 0; i < 4; ++i) { y0[i] = gelu_tanh(y0[i]); y1[i] = gelu_tanh(y1[i]); }
                    *(u32x4*)(Y + ((size_t)b * SEQ + k * 32 + t) * DM + g * 16 + c0) = pack8(y0, y1);
                }
            }
    }
};
}

struct Args { const float* in[33]; float* out; unsigned char* ws; };
typedef const __attribute__((address_space(4))) Args* ArgsP;
__device__ __forceinline__ ArgsP kargs() { ArgsP p = (ArgsP)__builtin_amdgcn_kernarg_segment_ptr(); asm volatile("" : "+s"(p)); return p; }

__device__ __forceinline__ float wave_sum(float v) {
    v += swz_xor<1>(v); v += swz_xor<2>(v); v += swz_xor<4>(v); v += swz_xor<8>(v); v += swz_xor<16>(v);
    return red32_add(v);
}

template <class Sched>
__device__ __forceinline__ void compute_rowscale(const Sched& S, const float* SS, LAS float* rs) {
    const int t = opaque_tid(), row = t >> 1, half = t & 1;
    pg8::Unit u;
    for (int ui = 0; S.next(ui, u); ++ui) {
        const float* p = SS + ((size_t)u.pm * 256 + row) * 32 + half * 16;
        const f32x4 a = *(const f32x4*)p, b = *(const f32x4*)(p + 4), c = *(const f32x4*)(p + 8), d = *(const f32x4*)(p + 12);
        float s = ((a[0] + a[1]) + (a[2] + a[3])) + ((b[0] + b[1]) + (b[2] + b[3])) + ((c[0] + c[1]) + (c[2] + c[3])) + ((d[0] + d[1]) + (d[2] + d[3]));
        s += swz_xor<1>(s);
        if (half == 0) rs[ui * 256 + row] = rsqrtf(s * (1.0f / 1024.0f) + EPS);
    }
    __syncthreads();
}

__device__ __forceinline__ void transpose_item(const float* W, int K, int srcN, int c0, int nvalid, const float* gain, bf16_t* WT, int n0, int k0, LAS float* scr, int lane) {
    const int cl = lane & 31;
#pragma unroll 8
    for (int i = 0; i < 32; ++i) { const int kk = 2 * i + (lane >> 5);
        float v = 0.f; if (cl < nvalid) { v = W[(size_t)(k0 + kk) * srcN + c0 + cl]; if (gain) v *= gain[k0 + kk]; }
        scr[kk * 33 + cl] = v; }
    asm volatile("s_waitcnt lgkmcnt(0)" ::: "memory");
    const int c = lane & 7;
#pragma unroll
    for (int j = 0; j < 4; ++j) { const int n = (lane >> 3) + 8 * j; const LAS float* s = scr + (8 * c) * 33 + n;
        u32x4 o; o.x = cvt_pk_bf16(s[0 * 33], s[1 * 33]); o.y = cvt_pk_bf16(s[2 * 33], s[3 * 33]); o.z = cvt_pk_bf16(s[4 * 33], s[5 * 33]); o.w = cvt_pk_bf16(s[6 * 33], s[7 * 33]);
        *(u32x4*)(WT + (size_t)(n0 + n) * K + k0 + 8 * c) = o; }
    asm volatile("s_waitcnt lgkmcnt(0)" ::: "memory");
}

__device__ __forceinline__ void convert_item(ArgsP a, int it, LAS float* scr, int lane) {
    unsigned char* ws = a->ws;
    if (it < 8 * 2816) {
        const int mi = it / 2816, r = it % 2816, l = mi >> 1, f = mi & 1;
        const int nblk = 5632 / 32, kb = r / nblk, nb = r % nblk, n0 = 32 * nb, pn = n0 >> 8, tc = n0 & 255, bj = tc >> 7, j = tc & 127;
        const float* W = (bj ? a->in[f ? 8 : 3] : a->in[f ? 7 : 2]) + (size_t)l * DM * FF;
        const float* gain = a->in[f ? 6 : 1] + l * DM;
        transpose_item(W, DM, FF, 128 * pn + j, 32, gain, (bf16_t*)(ws + WS_WGU + (size_t)mi * WGU_SZ), n0, 64 * kb, scr, lane);
        return;
    }
    it -= 8 * 2816;
    if (it < 8 * 1408) {
        const int mi = it / 1408, r = it % 1408, l = mi >> 1, f = mi & 1;
        const int nblk = 32, kb = r / nblk, nb = r % nblk;
        const float* W = a->in[f ? 9 : 4] + (size_t)l * FF * DM;
        transpose_item(W, FF, DM, 32 * nb, 32, nullptr, (bf16_t*)(ws + WS_WDN + (size_t)mi * WDN_SZ), 32 * nb, 64 * kb, scr, lane);
        return;
    }
    it -= 8 * 1408;
    const int j = it / 3200; int r = it % 3200;
    if (r < 1664) {
        const int nblk = 104, kb = r / nblk, nb = r % nblk, n0 = 32 * nb, pn = n0 >> 8, tc = n0 & 255;
        int c0, nvalid;
        if (pn < 12) { const int bj = tc >> 7, wc = (tc & 127) >> 5; c0 = (4 * pn + wc) * 64 + 32 * bj; nvalid = 32; }
        else { c0 = 3072; nvalid = (tc == 0) ? 8 : 0; }
        transpose_item(a->in[10] + (size_t)j * DM * 3080, DM, 3080, c0, nvalid, a->in[5] + (2 * j) * DM, (bf16_t*)(ws + WS_WIN + (size_t)j * WIN_SZ), n0, 64 * kb, scr, lane);
        return;
    }
    r -= 1664;
    if (r < 512) {
        const int nblk = 32, kb = r / nblk, nb = r % nblk;
        transpose_item(a->in[11] + (size_t)j * DM * DM, DM, DM, 32 * nb, 32, nullptr, (bf16_t*)(ws + WS_WOUT + (size_t)j * WOUT_SZ), 32 * nb, 64 * kb, scr, lane);
        return;
    }
    r -= 512;
    {
        const int nblk = 64, kb = r / nblk, nb = r % nblk, n0 = 32 * nb, pn = n0 >> 8, tc = n0 & 255, bj = tc >> 7, jj = tc & 127;
        const float* W = a->in[bj ? 32 : 31] + (size_t)j * DM * DM;
        transpose_item(W, DM, DM, 128 * pn + jj, 32, nullptr, (bf16_t*)(ws + WS_WGLU + (size_t)j * WGLU_SZ), n0, 64 * kb, scr, lane);
    }
}
constexpr int N_CONVERT_ITEMS = 8 * 2816 + 8 * 1408 + 2 * 3200;

__device__ void s5_setup(ArgsP a, int j, int g, LAS unsigned char* lds) {
    const int tid = opaque_tid();
    LAS float* lamp = (LAS float*)lds;
    LAS float* bbar = lamp + 64 * 33 * 2;
    LAS float* cc = bbar + 64 * 16 * 2;
    LAS float* Kt = cc + 16 * 64 * 2;
    const float step = __expf(a->in[25][j * 64 + g]);
    const float* are = a->in[23] + (size_t)(j * 64 + g) * 64; const float* aim = a->in[24] + (size_t)(j * 64 + g) * 64;
    for (int idx = tid; idx < 64 * 33; idx += 512) { const int p = idx / 33, k = idx % 33;
        const float mag = expf((float)k * are[p] * step), ang = (float)k * aim[p] * step; float sn, cs; sincosf(ang, &sn, &cs);
        lamp[idx * 2] = mag * cs; lamp[idx * 2 + 1] = mag * sn; }
    for (int idx = tid; idx < 1024; idx += 512) { const int p = idx >> 4, c = idx & 15;
        const float ar = are[p], ai = aim[p]; const float mag = expf(ar * step); float sn, cs; sincosf(ai * step, &sn, &cs);
        const float lr = mag * cs, li = mag * sn, den = ar * ar + ai * ai;
        const float cr = ((lr - 1.0f) * ar + li * ai) / den, ci = (li * ar - (lr - 1.0f) * ai) / den;
        const float br = a->in[26][((size_t)(j * 64 + g) * 64 + p) * 16 + c], bi = a->in[27][((size_t)(j * 64 + g) * 64 + p) * 16 + c];
        bbar[idx * 2] = cr * br - ci * bi; bbar[idx * 2 + 1] = cr * bi + ci * br;
        const int c2 = idx >> 6, p2 = idx & 63;
        cc[idx * 2] = a->in[28][((size_t)(j * 64 + g) * 16 + c2) * 64 + p2]; cc[idx * 2 + 1] = a->in[29][((size_t)(j * 64 + g) * 16 + c2) * 64 + p2]; }
    __syncthreads();
    {
        const int tau = tid >> 4, c = tid & 15;
        float acc[16];
#pragma unroll
        for (int i = 0; i < 16; ++i) acc[i] = 0.f;
        for (int p = 0; p < 64; ++p) {
            const float cr = cc[(c * 64 + p) * 2], ci = cc[(c * 64 + p) * 2 + 1], lr = lamp[(p * 33 + tau) * 2], li = lamp[(p * 33 + tau) * 2 + 1];
            const float zr = cr * lr - ci * li, zi = cr * li + ci * lr;
#pragma unroll
            for (int i = 0; i < 16; ++i) acc[i] += zr * bbar[(p * 16 + i) * 2] - zi * bbar[(p * 16 + i) * 2 + 1];
        }
#pragma unroll
        for (int i = 0; i < 16; ++i) Kt[tau * 256 + c * 16 + i] = acc[i];
    }
    __syncthreads();
    bf16_t* W1 = (bf16_t*)(a->ws + WS_S5W1) + (size_t)g * 256 * 512;
    for (int ch = tid; ch < 256 * 64; ch += 512) {
        const int row = ch >> 6, c8 = ch & 63; float v[8];
        if (row < 128) { const int p = row & 63, s = c8 >> 1, c0 = (c8 & 1) * 8; const float lr = lamp[(p * 33 + 31 - s) * 2], li = lamp[(p * 33 + 31 - s) * 2 + 1];
#pragma unroll
            for (int i = 0; i < 8; ++i) { const float br = bbar[(p * 16 + c0 + i) * 2], bi = bbar[(p * 16 + c0 + i) * 2 + 1]; v[i] = row < 64 ? (lr * br - li * bi) : (lr * bi + li * br); } }
        else {
#pragma unroll
            for (int i = 0; i < 8; ++i) v[i] = 0.f; }
        u32x4 o; o.x = cvt_pk_bf16(v[0], v[1]); o.y = cvt_pk_bf16(v[2], v[3]); o.z = cvt_pk_bf16(v[4], v[5]); o.w = cvt_pk_bf16(v[6], v[7]);
        *(u32x4*)(W1 + (size_t)row * 512 + c8 * 8) = o;
    }
    bf16_t* WA = (bf16_t*)(a->ws + WS_S5WA) + (size_t)g * 512 * 640;
    for (int ch = tid; ch < 512 * 80; ch += 512) {
        const int row = ch / 80, c8 = ch % 80, t = row >> 4, c = row & 15; float v[8];
        if (c8 < 64) { const int s = c8 >> 1, c0 = (c8 & 1) * 8;
#pragma unroll
            for (int i = 0; i < 8; ++i) v[i] = (s <= t) ? Kt[(t - s) * 256 + c * 16 + c0 + i] : 0.f; }
        else { const int pb = (c8 - 64) * 8;
#pragma unroll
            for (int i = 0; i < 8; ++i) { const int pp = pb + i, p = pp & 63; const float cr = cc[(c * 64 + p) * 2], ci = cc[(c * 64 + p) * 2 + 1], lr = lamp[(p * 33 + t + 1) * 2], li = lamp[(p * 33 + t + 1) * 2 + 1];
                v[i] = pp < 64 ? (cr * lr - ci * li) : -(cr * li + ci * lr); } }
        u32x4 o; o.x = cvt_pk_bf16(v[0], v[1]); o.y = cvt_pk_bf16(v[2], v[3]); o.z = cvt_pk_bf16(v[4], v[5]); o.w = cvt_pk_bf16(v[6], v[7]);
        *(u32x4*)(WA + (size_t)row * 640 + c8 * 8) = o;
    }
    __syncthreads();
}

__device__ void s5_build_u(ArgsP a, int layer, LAS unsigned char* lds) {
    const int tid = opaque_tid(), lane = tid & 63, wid = tid >> 6;
    const bf16_t* XB = (const bf16_t*)(a->ws + WS_XB); const float* SS = (const float*)(a->ws + WS_SS);
    bf16_t* UA = (bf16_t*)(a->ws + WS_R + R_UA);
    const float* gain = a->in[5] + layer * DM;
    LAS float* rsl = (LAS float*)(lds + 32 * 2064);
    for (int n = blockIdx.x; n < 1024; n += gridDim.x) {
        const size_t tok0 = (size_t)(n >> 7) * SEQ + (size_t)(n & 127) * 32;
        if (tid < 256) { const int row = tid >> 3, part = tid & 7; const f32x4 v = *(const f32x4*)(SS + (tok0 + row) * 32 + part * 4);
            float s = (v[0] + v[1]) + (v[2] + v[3]); s += swz_xor<1>(s); s += swz_xor<2>(s); s += swz_xor<4>(s);
            if (part == 0) rsl[row] = rsqrtf(s * (1.0f / 1024.0f) + EPS); }
        __syncthreads();
#pragma unroll
        for (int i = 0; i < 8; ++i) { const int id = i * 512 + tid, row = id >> 7, c16 = id & 127;
            const u32x4 w = *(const u32x4*)(XB + (tok0 + row) * DM + c16 * 8); const float r = rsl[row];
            const f32x4 g0 = *(const f32x4*)(gain + c16 * 8), g1 = *(const f32x4*)(gain + c16 * 8 + 4);
            u32x4 o; o.x = cvt_pk_bf16(bf_lo(w.x) * r * g0[0], bf_hi(w.x) * r * g0[1]); o.y = cvt_pk_bf16(bf_lo(w.y) * r * g0[2], bf_hi(w.y) * r * g0[3]);
            o.z = cvt_pk_bf16(bf_lo(w.z) * r * g1[0], bf_hi(w.z) * r * g1[1]); o.w = cvt_pk_bf16(bf_lo(w.w) * r * g1[2], bf_hi(w.w) * r * g1[3]);
            *(LAS u32x4*)(lds + row * 2064 + c16 * 16) = o; }
        __syncthreads();
#pragma unroll
        for (int gg = 0; gg < 8; ++gg) { const int g = wid * 8 + gg, s = lane >> 1, half = lane & 1;
            const u32x4 v = *(const LAS u32x4*)(lds + s * 2064 + g * 32 + half * 16);
            *(u32x4*)(UA + ((size_t)g * 1024 + n) * 640 + lane * 8) = v; }
        __syncthreads();
    }
}

__device__ void s5_scan(ArgsP a, int j) {
    const int gt = blockIdx.x * 512 + opaque_tid();
    if (gt >= 32768) return;
    const int p = gt & 63, g = (gt >> 6) & 63, b = gt >> 12;
    const float step = __expf(a->in[25][j * 64 + g]);
    const float ar = a->in[23][(size_t)(j * 64 + g) * 64 + p], ai = a->in[24][(size_t)(j * 64 + g) * 64 + p];
    const float mag = expf(32.0f * ar * step); float sn, cs; sincosf(32.0f * ai * step, &sn, &cs);
    const float lr = mag * cs, li = mag * sn;
    const float* SST = (const float*)(a->ws + WS_R + R_SST) + ((size_t)g * 1024 + b * 128) * 128;
    bf16_t* UA = (bf16_t*)(a->ws + WS_R + R_UA) + ((size_t)g * 1024 + b * 128) * 640 + 512;
    float xr = 0.f, xi = 0.f;
    for (int k0 = 0; k0 < 128; k0 += 8) {
        float sr[8], si[8];
#pragma unroll
        for (int i = 0; i < 8; ++i) { sr[i] = SST[(size_t)(k0 + i) * 128 + p]; si[i] = SST[(size_t)(k0 + i) * 128 + 64 + p]; }
#pragma unroll
        for (int i = 0; i < 8; ++i) {
            UA[(size_t)(k0 + i) * 640 + p] = (bf16_t)(cvt_pk_bf16(xr, 0.f) & 0xffffu); UA[(size_t)(k0 + i) * 640 + 64 + p] = (bf16_t)(cvt_pk_bf16(xi, 0.f) & 0xffffu);
            const float nr = lr * xr - li * xi + sr[i], ni = lr * xi + li * xr + si[i]; xr = nr; xi = ni;
        }
    }
}

__device__ void cumsum_bh(ArgsP a, int bh, LAS unsigned char* lds) {
    const int tid = opaque_tid(), lane = tid & 63, wid = tid >> 6, b = bh >> 3, h = bh & 7;
    const float* LF = (const float*)(a->ws + WS_LF) + ((size_t)b * SEQ + tid * 8) * 8 + h;
    float v[8]; float run = 0.f;
#pragma unroll
    for (int i = 0; i < 8; ++i) { run += LF[i * 8]; v[i] = run; }
    LAS float* tot = (LAS float*)lds;
    tot[tid] = run;
    __syncthreads();
    float off = 0.f;
    for (int u = 0; u < tid; ++u) off += tot[u];
    float* C = (float*)(a->ws + WS_CUM) + (size_t)bh * SEQ + tid * 8;
#pragma unroll
    for (int i = 0; i < 8; ++i) C[i] = (off + v[i]) * LOG2E;
    __syncthreads();
}

__device__ __forceinline__ int crow(int r, int hi) { return (r & 3) + 8 * (r >> 2) + 4 * hi; }
__device__ __forceinline__ void glds16(const void* g, LAS void* l) { __builtin_amdgcn_global_load_lds((const unsigned*)g, (LAS unsigned*)l, 16, 0, 0); }
__device__ __forceinline__ void glds4(const void* g, LAS void* l) { __builtin_amdgcn_global_load_lds((const unsigned*)g, (LAS unsigned*)l, 4, 0, 0); }
__device__ __forceinline__ s16x4 vtr(const LAS char* p) { return __builtin_bit_cast(s16x4, __builtin_amdgcn_ds_read_tr16_b64_v4i16((LAS s16x4*)p)); }

constexpr int AT_STAGE = 32768, AT_CK = 65536, AT_TB = 66048, AT_WSF = 66560, AT_XCH = 68608, AT_MISC = 69632;

struct AttnP { const bf16_t *Q, *K, *V; bf16_t* O; const float* cum; const float* relb; const float* subg; float lam, lam_init; };

template <int NMAP>
__device__ __forceinline__ void attn_unit(LAS unsigned char* lds, const AttnP& P, int b, int h, int qb) {
    const int tid = opaque_tid(), lane = tid & 63, r32 = lane & 31, hi = lane >> 5, wid = __builtin_amdgcn_readfirstlane(tid >> 6);
    constexpr int QROWS = NMAP == 1 ? 256 : 128;
    const int q0 = qb * QROWS;
    const int rb = NMAP == 1 ? wid : (wid >> 1), vh = NMAP == 1 ? 0 : (wid & 1);
    const int qw0 = q0 + rb * 32;
    const size_t rowbase = (size_t)b * SEQ;
    const int colqk = NMAP == 1 ? 512 + h * 64 : h * 128;
    const int NT = (q0 + QROWS) >> 6, tl = (qw0 + 31) >> 6;
    const int bh = b * 8 + h;
    LAS float* wsf = (LAS float*)(lds + AT_WSF) + wid * 64;
    LAS float* tb = (LAS float*)(lds + AT_TB);
    LAS float* xch = (LAS float*)(lds + AT_XCH);

    if (NMAP == 2 && tid < 128) {
        int bk = tid; if (tid >= 16) { bk = 16 + (int)(logf((float)tid * (1.0f / 16.0f)) / 2.0794415416798357f * 16.0f); bk = bk < 31 ? bk : 31; }
        tb[tid] = (P.relb[bk * 4 + h] - P.relb[31 * 4 + h]) * LOG2E;
    }
    bf16x8 qr[NMAP][4];
#pragma unroll
    for (int m = 0; m < NMAP; ++m)
#pragma unroll
        for (int d0 = 0; d0 < 4; ++d0) qr[m][d0] = *(const bf16x8*)(P.Q + (rowbase + qw0 + r32) * DM + colqk + m * 64 + d0 * 16 + hi * 8);
    float cq = 0.f; if (NMAP == 1) cq = P.cum[(size_t)bh * SEQ + qw0 + r32];

    auto issue = [&](int t, int st) {
        LAS unsigned char* sb = lds + st * AT_STAGE;
        const bf16_t* kp = P.K + (rowbase + 64 * t + lane) * DM + colqk + wid * 8;
#pragma unroll
        for (int m = 0; m < NMAP; ++m) glds16(kp + m * 64, sb + m * 8192 + wid * 1024);
#pragma unroll
        for (int q = 0; q < NMAP; ++q) { const int pp = wid + 8 * q, dblk = pp >> 2, kvb = pp & 3;
            glds16(P.V + (rowbase + 64 * t + 16 * kvb + (lane >> 2)) * DM + colqk + dblk * 32 + (lane & 3) * 8, sb + 16384 + pp * 1024); }
        if (NMAP == 1 && wid == 0) glds4(P.cum + (size_t)bh * SEQ + 64 * t + lane, lds + AT_CK + st * 256);
    };

    float mref[NMAP], lsum[NMAP]; f32x16 o[NMAP][2];
#pragma unroll
    for (int m = 0; m < NMAP; ++m) { mref[m] = -1e30f; lsum[m] = 0.f; o[m][0] = f32x16{}; o[m][1] = f32x16{}; }

    issue(0, 0);
    for (int t = 0; t < NT; ++t) {
        const int st = t & 1;
        asm volatile("s_waitcnt vmcnt(0)" ::: "memory");
        __syncthreads();
        if (t + 1 < NT) issue(t + 1, st ^ 1);
        if (t <= tl) {
            const LAS char* sb = (const LAS char*)(lds + st * AT_STAGE);
            bf16x8 vf[2][4];
            { const LAS char* vp = sb + 16384 + ((lane >> 4) & 1) * 32 + (lane & 3) * 8 + (4 * hi + ((lane & 15) >> 2)) * 64;
#pragma unroll
              for (int d0 = 0; d0 < 2; ++d0)
#pragma unroll
                for (int ks = 0; ks < 4; ++ks) { const s16x4 lo = vtr(vp + (2 * vh + d0) * 4096 + ks * 1024), hh = vtr(vp + (2 * vh + d0) * 4096 + ks * 1024 + 512);
                    vf[d0][ks] = (bf16x8){lo[0], lo[1], lo[2], lo[3], hh[0], hh[1], hh[2], hh[3]}; } }
            const bool need_mask = (64 * t + 63 > qw0);
            const bool need_bias = (NMAP == 2) && (64 * t + 63 + 113 > qw0);
#pragma unroll
            for (int m = 0; m < NMAP; ++m) {
                f32x16 p[2]; p[0] = f32x16{}; p[1] = f32x16{};
                { const LAS char* kb = sb + m * 8192 + hi * 1024 + r32 * 16;
#pragma unroll
                  for (int d0 = 0; d0 < 4; ++d0) { const bf16x8 b0 = *(const LAS bf16x8*)(kb + d0 * 2048), b1 = *(const LAS bf16x8*)(kb + d0 * 2048 + 512);
                      p[0] = __builtin_amdgcn_mfma_f32_32x32x16_bf16(b0, qr[m][d0], p[0], 0, 0, 0); p[1] = __builtin_amdgcn_mfma_f32_32x32x16_bf16(b1, qr[m][d0], p[1], 0, 0, 0); } }
                if (NMAP == 1) {
                    const LAS float* ck = (const LAS float*)(lds + AT_CK + st * 256);
#pragma unroll
                    for (int j = 0; j < 8; ++j) { const f32x4 c = *(const LAS f32x4*)(ck + 4 * hi + 8 * j);
#pragma unroll
                        for (int i = 0; i < 4; ++i) p[j >> 2][4 * (j & 3) + i] += cq - c[i]; }
                } else if (need_bias) {
                    const int qd = qw0 + r32 - 64 * t - 4 * hi;
#pragma unroll
                    for (int j = 0; j < 8; ++j)
#pragma unroll
                        for (int i = 0; i < 4; ++i) { int n = qd - 8 * j - i; n = n < 0 ? 0 : (n > 127 ? 127 : n); p[j >> 2][4 * (j & 3) + i] += tb[n]; }
                }
                if (need_mask) {
                    const int qd = qw0 + r32 - 64 * t - 4 * hi;
#pragma unroll
                    for (int j = 0; j < 8; ++j)
#pragma unroll
                        for (int i = 0; i < 4; ++i) if (8 * j + i > qd) p[j >> 2][4 * (j & 3) + i] = -INFINITY;
                }
                float rm = p[0][0];
#pragma unroll
                for (int r = 1; r < 16; ++r) rm = fmaxf(rm, p[0][r]);
#pragma unroll
                for (int r = 0; r < 16; ++r) rm = fmaxf(rm, p[1][r]);
                rm = red32_max(rm);
                if (__any(rm > mref[m] + 8.0f)) {
                    const float nm = fmaxf(mref[m], rm), al = fast_exp2(mref[m] - nm);
                    mref[m] = nm; lsum[m] *= al;
                    asm volatile("s_waitcnt lgkmcnt(0)" ::: "memory");
                    if (hi == 0) wsf[r32] = al;
                    asm volatile("s_waitcnt lgkmcnt(0)" ::: "memory");
#pragma unroll
                    for (int r = 0; r < 16; ++r) { const float f = wsf[crow(r, hi)]; o[m][0][r] *= f; o[m][1][r] *= f; }
                    asm volatile("s_waitcnt lgkmcnt(0)" ::: "memory");
                }
                float sa = 0.f;
#pragma unroll
                for (int r = 0; r < 16; ++r) { p[0][r] = fast_exp2(p[0][r] - mref[m]); p[1][r] = fast_exp2(p[1][r] - mref[m]); sa += p[0][r] + p[1][r]; }
                lsum[m] += sa;
                bf16x8 pw[4];
#pragma unroll
                for (int ks = 0; ks < 4; ++ks) { const int hp = ks >> 1, bs = 8 * (ks & 1);
                    u32x4 w; w.x = cvt_pk_bf16(p[hp][bs + 0], p[hp][bs + 1]); w.y = cvt_pk_bf16(p[hp][bs + 2], p[hp][bs + 3]); w.z = cvt_pk_bf16(p[hp][bs + 4], p[hp][bs + 5]); w.w = cvt_pk_bf16(p[hp][bs + 6], p[hp][bs + 7]);
                    pw[ks] = __builtin_bit_cast(bf16x8, w); }
#pragma unroll
                for (int d0 = 0; d0 < 2; ++d0)
#pragma unroll
                    for (int ks = 0; ks < 4; ++ks) o[m][d0] = __builtin_amdgcn_mfma_f32_32x32x16_bf16(pw[ks], vf[d0][ks], o[m][d0], 0, 0, 0);
            }
        }
    }
    float inv[NMAP][16];
#pragma unroll
    for (int m = 0; m < NMAP; ++m) {
        const float lt = red32_add(lsum[m]);
        asm volatile("s_waitcnt lgkmcnt(0)" ::: "memory");
        if (hi == 0) wsf[r32] = fast_rcp(lt);
        asm volatile("s_waitcnt lgkmcnt(0)" ::: "memory");
#pragma unroll
        for (int r = 0; r < 16; ++r) inv[m][r] = wsf[crow(r, hi)];
        asm volatile("s_waitcnt lgkmcnt(0)" ::: "memory");
    }
    if (NMAP == 1) {
        bf16_t* Ow = P.O + (rowbase + qw0) * DM + 512 + h * 64 + r32;
#pragma unroll
        for (int r = 0; r < 16; ++r)
#pragma unroll
            for (int d0 = 0; d0 < 2; ++d0) Ow[(size_t)crow(r, hi) * DM + d0 * 32] = (bf16_t)(cvt_pk_bf16(o[0][d0][r] * inv[0][r], 0.f) & 0xffffu);
        __syncthreads();
    } else {
        float val[2][16]; float ss[16];
#pragma unroll
        for (int r = 0; r < 16; ++r) {
#pragma unroll
            for (int d0 = 0; d0 < 2; ++d0) val[d0][r] = o[0][d0][r] * inv[0][r] - P.lam * (o[NMAP - 1][d0][r] * inv[NMAP - 1][r]);
            float s = val[0][r] * val[0][r] + val[1][r] * val[1][r];
            s += swz_xor<1>(s); s += swz_xor<2>(s); s += swz_xor<4>(s); s += swz_xor<8>(s); s += swz_xor<16>(s);
            ss[r] = s;
        }
        if (r32 == 0) {
#pragma unroll
            for (int r = 0; r < 16; ++r) xch[wid * 32 + crow(r, hi)] = ss[r];
        }
        __syncthreads();
        const float g0 = P.subg[vh * 64 + r32], g1 = P.subg[vh * 64 + 32 + r32];
        bf16_t* Ow = P.O + (rowbase + qw0) * DM + h * 128 + vh * 64 + r32;
#pragma unroll
        for (int r = 0; r < 16; ++r) {
            const float tot = ss[r] + xch[(wid ^ 1) * 32 + crow(r, hi)];
            const float rn = rsqrtf(tot * (1.0f / 128.0f) + EPS) * (1.0f - P.lam_init);
            Ow[(size_t)crow(r, hi) * DM] = (bf16_t)(cvt_pk_bf16(val[0][r] * rn * g0, 0.f) & 0xffffu);
            Ow[(size_t)crow(r, hi) * DM + 32] = (bf16_t)(cvt_pk_bf16(val[1][r] * rn * g1, 0.f) & 0xffffu);
        }
        __syncthreads();
    }
}

__device__ void attn_phase(ArgsP a, int j, LAS unsigned char* lds) {
    const int tid = opaque_tid(), lane = tid & 63;
    AttnP P;
    P.Q = (const bf16_t*)(a->ws + WS_R + R_Q); P.K = (const bf16_t*)(a->ws + WS_R + R_K); P.V = (const bf16_t*)(a->ws + WS_R + R_V); P.O = (bf16_t*)(a->ws + WS_R + R_Q);
    P.cum = (const float*)(a->ws + WS_CUM); P.relb = a->in[22]; P.subg = a->in[19] + j * 128;
    const float d1 = wave_sum(a->in[15][j * 64 + lane] * a->in[16][j * 64 + lane]), d2 = wave_sum(a->in[17][j * 64 + lane] * a->in[18][j * 64 + lane]);
    const int jo = opaque_s(j);
    const float li_ = (jo == 0) ? 0.2f : 0.47071301821013583f;
    P.lam_init = li_;
    P.lam = __int_as_float(__builtin_amdgcn_readfirstlane(__float_as_int(expf(d1) - expf(d2) + li_)));
    unsigned* ctr = (unsigned*)(a->ws + WS_CTL) + 64 * (1 + j);
    LAS unsigned* misc = (LAS unsigned*)(lds + AT_MISC);
    for (;;) {
        if (tid == 0) misc[0] = atomicAdd(ctr, 1u);
        __syncthreads();
        const int idx = (int)misc[0];
        __syncthreads();
        if (idx >= 2048) break;
        int type, bh, L;
        if (idx < 512) { L = 32 - (idx >> 5); type = 1; bh = idx & 31; }
        else { const int jj = idx - 512; L = 16 - jj / 96; const int r = jj % 96; if (r < 32) { type = 1; bh = r; } else { type = 0; bh = r - 32; } }
        if (type == 0) attn_unit<1>(lds, P, bh >> 3, bh & 7, L - 1);
        else attn_unit<2>(lds, P, bh >> 2, bh & 3, L - 1);
    }
}

__device__ __forceinline__ void grid_barrier(unsigned* bar, unsigned G, unsigned& k) {
    const int tid = opaque_tid();
    asm volatile("s_waitcnt vmcnt(0) lgkmcnt(0)" ::: "memory");
    __syncthreads();
    if (tid == 0) {
        __builtin_amdgcn_fence(__ATOMIC_RELEASE, "agent");
        asm volatile("s_waitcnt vmcnt(0)" ::: "memory");
        __hip_atomic_fetch_add(bar, 1u, __ATOMIC_RELAXED, __HIP_MEMORY_SCOPE_AGENT);
        const unsigned target = (k + 1u) * G; unsigned spins = 0;
        while (__hip_atomic_load(bar, __ATOMIC_RELAXED, __HIP_MEMORY_SCOPE_AGENT) < target) { __builtin_amdgcn_s_sleep(2); if (++spins > (1u << 24)) break; }
        __builtin_amdgcn_fence(__ATOMIC_ACQUIRE, "agent");
        asm volatile("s_waitcnt vmcnt(0)" ::: "memory");
    }
    __syncthreads();
    ++k;
}

__global__ void __launch_bounds__(512, 2) fwd_megakernel(Args a_unused) {
    LAS unsigned char* lds = (LAS unsigned char*)lds_raw;
    cg::grid_group grid = cg::this_grid();
    const int G0 = gridDim.x, bx0 = blockIdx.x;
#define G opaque_s(G0)
#define bx opaque_s(bx0)
    LAS float* rs = (LAS float*)(lds + LDS_RS);
    { const int t0 = threadIdx.x; const int key = hw_wave_key(); if ((t0 & 63) == 0) *(volatile LAS int*)(lds + LDS_WIDTAB + key * 4) = t0 >> 6; }
    grid.sync();
    unsigned bar_k = 0;
#define GRID_SYNC() grid_barrier((unsigned*)(kargs()->ws + WS_CTL), (unsigned)G, bar_k)

    {
        ArgsP a = kargs();
        const int tid = opaque_tid(), lane = tid & 63, wid = tid >> 6, Gp = G, bxp = bx;
        if (bxp >= Gp - 64) s5_setup(a, 0, bxp - (Gp - 64), lds);
        LAS float* scr = (LAS float*)(lds + wid * 16384);
        const int gw = bxp * 8 + wid, NGW = Gp * 8;
        for (int it = gw; it < N_CONVERT_ITEMS; it += NGW) convert_item(a, it, scr, lane);
        float* X = a->out; bf16_t* XB = (bf16_t*)(a->ws + WS_XB); float* SS = (float*)(a->ws + WS_SS); const float* xin = a->in[0];
        for (int m = gw; m < MTOK; m += NGW) {
            const f32x4* xr = (const f32x4*)(xin + (size_t)m * DM) + lane; f32x4* orow = (f32x4*)(X + (size_t)m * DM) + lane;
            u32x2* ob = (u32x2*)(XB + (size_t)m * DM) + lane;
            float s = 0.f;
#pragma unroll
            for (int jx = 0; jx < 4; ++jx) { const f32x4 v = xr[64 * jx]; s += (v[0] * v[0] + v[1] * v[1]) + (v[2] * v[2] + v[3] * v[3]); orow[64 * jx] = v;
                u32x2 w; w.x = cvt_pk_bf16(v[0], v[1]); w.y = cvt_pk_bf16(v[2], v[3]); ob[64 * jx] = w; }
            s = wave_sum(s);
            if (lane < 32) SS[(size_t)m * 32 + lane] = lane == 0 ? s : 0.f;
        }
    }
    GRID_SYNC();

#pragma unroll 1
    for (int layer = 0; layer < 4; ++layer) {
        const int j = layer >> 1;
#pragma unroll 1
        for (int f = 0; f < 2; ++f) {
            if (f == 1) {
                if ((layer & 1) == 0) {
                    {
                        ArgsP a = kargs(); unsigned char* ws = a->ws;
                        {
                            const int t = opaque_tid();
                            if (t < 256) { const int sel = t >> 6, d = t & 63; const float* gp = a->in[sel == 0 ? 13 : (sel == 1 ? 14 : (sel == 2 ? 20 : 21))]; ((LAS float*)(lds + LDS_GT))[t] = gp[j * 64 + d]; }
                        }
                        pg8::Gemm g{(const bf16_t*)(ws + WS_XB), (const bf16_t*)(ws + WS_WIN + (size_t)j * WIN_SZ), DM, DM, DM};
                        pg8::StaticOrder S; S.init(MTOK, 3328, G, bx);
                        compute_rowscale(S, (const float*)(ws + WS_SS), rs);
                        pg8::EpiInProj E{(bf16_t*)(ws + WS_R + R_Q), (float*)(ws + WS_LF), rs, (const LAS float*)(lds + LDS_GT), a->in[12] + j * 8};
                        pg8::gemm_phase(lds, g, S, E);
                    }
                    GRID_SYNC();
                    {
                        ArgsP a = kargs();
                        const int bxp = bx;
                        if (bxp < 64) cumsum_bh(a, bxp, lds);
                        else if (j == 1 && bxp >= 128 && bxp < 192) s5_setup(a, 1, bxp - 128, lds);
                    }
                    GRID_SYNC();
                    attn_phase(kargs(), j, lds);
                    GRID_SYNC();
                    {
                        ArgsP a = kargs(); unsigned char* ws = a->ws;
                        pg8::Gemm g{(const bf16_t*)(ws + WS_R + R_Q), (const bf16_t*)(ws + WS_WOUT + (size_t)j * WOUT_SZ), DM, DM, DM};
                        pg8::StaticOrder S; S.init(MTOK, DM, G, bx);
                        pg8::EpiResAdd E{a->out, (bf16_t*)(ws + WS_XB), (float*)(ws + WS_SS), 1.0f};
                        pg8::gemm_phase(lds, g, S, E);
                    }
                    GRID_SYNC();
                } else {
                    s5_build_u(kargs(), layer, lds);
                    GRID_SYNC();
                    {
                        ArgsP a = kargs(); unsigned char* ws = a->ws;
                        pg8::Gemm g{(const bf16_t*)(ws + WS_R + R_UA), (const bf16_t*)(ws + WS_S5W1), 640, 512, 512};
                        pg8::S5StateOrder S{G, bx};
                        pg8::EpiS5State E{(float*)(ws + WS_R + R_SST)};
                        pg8::gemm_phase(lds, g, S, E);
                    }
                    GRID_SYNC();
                    s5_scan(kargs(), j);
                    GRID_SYNC();
                    {
                        ArgsP a = kargs(); unsigned char* ws = a->ws;
                        pg8::Gemm g{(const bf16_t*)(ws + WS_R + R_UA), (const bf16_t*)(ws + WS_S5WA), 640, 640, 640};
                        pg8::S5OutOrder S{G, bx};
                        pg8::EpiS5Out E{(const bf16_t*)(ws + WS_R + R_UA), a->in[30] + j * DM, (bf16_t*)(ws + WS_R + R_Y)};
                        pg8::gemm_phase(lds, g, S, E);
                    }
                    GRID_SYNC();
                    {
                        ArgsP a = kargs(); unsigned char* ws = a->ws;
                        pg8::Gemm g{(const bf16_t*)(ws + WS_R + R_Y), (const bf16_t*)(ws + WS_WGLU + (size_t)j * WGLU_SZ), DM, DM, DM};
                        pg8::StaticOrder S; S.init(MTOK, 2048, G, bx);
                        pg8::EpiGlu E{a->out, (bf16_t*)(ws + WS_XB), (float*)(ws + WS_SS)};
                        pg8::gemm_phase(lds, g, S, E);
                    }
                    GRID_SYNC();
                }
            }
            const int mi = layer * 2 + f;
            {
                ArgsP a = kargs(); unsigned char* ws = a->ws;
                pg8::Gemm g{(const bf16_t*)(ws + WS_XB), (const bf16_t*)(ws + WS_WGU + (size_t)mi * WGU_SZ), DM, DM, DM};
                pg8::StaticOrder S; S.init(MTOK, 5632, G, bx);
                compute_rowscale(S, (const float*)(ws + WS_SS), rs);
                pg8::EpiGateUp E{(bf16_t*)(ws + WS_R + R_H), rs};
                pg8::gemm_phase(lds, g, S, E);
            }
            GRID_SYNC();
            {
                ArgsP a = kargs(); unsigned char* ws = a->ws;
                pg8::Gemm g{(const bf16_t*)(ws + WS_R + R_H), (const bf16_t*)(ws + WS_WDN + (size_t)mi * WDN_SZ), FF, FF, FF};
                pg8::StaticOrder S; S.init(MTOK, DM, G, bx);
                pg8::EpiResAdd E{a->out, (bf16_t*)(ws + WS_XB), (float*)(ws + WS_SS), 0.5f};
                pg8::gemm_phase(lds, g, S, E);
            }
            GRID_SYNC();
        }
    }
}
#undef G
#undef bx
#undef GRID_SYNC

extern "C" void kernel_launch(void* const* d_in, const int* in_sizes, int n_in, void* d_out, int out_size, void* d_ws, size_t ws_size, hipStream_t stream) {
    static int grid = 0;
    if (grid == 0) {
        if (n_in != 33 || out_size != MTOK * DM || ws_size < WS_END) { fprintf(stderr, "kernel_launch: unexpected shapes (n_in %d out %d ws %zu, need ws >= %zu)\n", n_in, out_size, ws_size, (size_t)WS_END); grid = -1; return; }
        int dev = 0, cus = 0, per_cu = 0;
        hipGetDevice(&dev); hipDeviceGetAttribute(&cus, hipDeviceAttributeMultiprocessorCount, dev);
        hipFuncSetAttribute((const void*)fwd_megakernel, hipFuncAttributeMaxDynamicSharedMemorySize, LDS_BYTES);
        hipOccupancyMaxActiveBlocksPerMultiprocessor(&per_cu, (const void*)fwd_megakernel, 512, LDS_BYTES);
        (void)hipGetLastError();
        if (per_cu < 1) { fprintf(stderr, "kernel_launch: occupancy query says %d blocks/CU\n", per_cu); per_cu = 1; }
        grid = cus;
        if (grid != 256) fprintf(stderr, "kernel_launch: warning: %d CUs (built for 256)\n", grid);
    }
    if (grid < 0) return;
    hipMemsetAsync((char*)d_ws + WS_CTL, 0, 4096, stream);
    Args a{};
    for (int i = 0; i < 33; ++i) a.in[i] = (const float*)d_in[i];
    a.out = (float*)d_out; a.ws = (unsigned char*)d_ws;
    void* args[] = {&a};
    hipError_t e = hipLaunchCooperativeKernel((const void*)fwd_megakernel, dim3(grid), dim3(512), args, LDS_BYTES, stream);
    if (e != hipSuccess) fprintf(stderr, "cooperative launch failed: %s (grid %d)\n", hipGetErrorString(e), grid);
}
```

```cpp
#include <hip/hip_runtime.h>
#include <hip/hip_cooperative_groups.h>
#include <cstdio>
#include <cstdint>
#include <cmath>
namespace cg = cooperative_groups;

#define LAS __attribute__((address_space(3)))
typedef unsigned short bf16_t;
typedef short bf16x8 __attribute__((ext_vector_type(8)));
typedef short s16x4 __attribute__((ext_vector_type(4)));
typedef float f32x4 __attribute__((ext_vector_type(4)));
typedef float f32x16 __attribute__((ext_vector_type(16)));
typedef unsigned u32x4 __attribute__((ext_vector_type(4)));
typedef unsigned u32x2 __attribute__((ext_vector_type(2)));

constexpr int MTOK = 32768, DM = 1024, FF = 2816, SEQ = 4096, NB = 8;
constexpr float EPS = 1e-6f;
constexpr float LOG2E = 1.4426950408889634f;
constexpr float QSCALE = 0.125f * LOG2E;

constexpr size_t MiB = 1u << 20;
constexpr size_t WS_CTL = 0;
constexpr size_t WS_SS = 1 * MiB;
constexpr size_t WS_LF = 5 * MiB;
constexpr size_t WS_CUM = 6 * MiB;
constexpr size_t WS_WGU = 8 * MiB;
constexpr size_t WGU_SZ = (size_t)5632 * 1024 * 2;
constexpr size_t WS_WDN = 96 * MiB;
constexpr size_t WDN_SZ = (size_t)1024 * 2816 * 2;
constexpr size_t WS_WIN = 140 * MiB;
constexpr size_t WIN_SZ = (size_t)3328 * 1024 * 2;
constexpr size_t WS_WOUT = 153 * MiB;
constexpr size_t WOUT_SZ = (size_t)1024 * 1024 * 2;
constexpr size_t WS_WGLU = 157 * MiB;
constexpr size_t WGLU_SZ = (size_t)2048 * 1024 * 2;
constexpr size_t WS_S5W1 = 165 * MiB;
constexpr size_t WS_S5WA = 181 * MiB;
constexpr size_t WS_XB = 221 * MiB;
constexpr size_t WS_R = 285 * MiB;
constexpr size_t WS_END = 477 * MiB;
constexpr size_t R_H = 0;
constexpr size_t R_Q = 0, R_K = 64 * MiB, R_V = 128 * MiB;
constexpr size_t R_UA = 0;
constexpr size_t R_SST = 80 * MiB;
constexpr size_t R_Y = 112 * MiB;

constexpr int LDS_BYTES = 147456;
constexpr int LDS_RS = 131072;
constexpr int LDS_GT = 131072 + 12288;

typedef float f32x2_t __attribute__((ext_vector_type(2))); typedef __bf16 bf16x2_t __attribute__((ext_vector_type(2)));
__device__ __forceinline__ unsigned cvt_pk_bf16(float lo, float hi) { const f32x2_t v = {lo, hi}; const bf16x2_t b = __builtin_convertvector(v, bf16x2_t); return __builtin_bit_cast(unsigned, b); }
__device__ __forceinline__ float bf_lo(unsigned w) { return __uint_as_float(w << 16); }
__device__ __forceinline__ float bf_hi(unsigned w) { return __uint_as_float(w & 0xffff0000u); }
__device__ __forceinline__ float fast_exp2(float x) { return __builtin_amdgcn_exp2f(x); }
__device__ __forceinline__ float fast_rcp(float x) { return __builtin_amdgcn_rcpf(x); }
__device__ __forceinline__ float sigmoidf_(float x) { return fast_rcp(1.0f + fast_exp2(-x * LOG2E)); }
__device__ __forceinline__ float gelu_tanh(float y) { const float z = 1.5957691216057308f * (y + 0.044715f * y * y * y); return y * sigmoidf_(z); }
__device__ __forceinline__ u32x4 pack8(f32x4 a, f32x4 b) { u32x4 w; w.x = cvt_pk_bf16(a[0], a[1]); w.y = cvt_pk_bf16(a[2], a[3]); w.z = cvt_pk_bf16(b[0], b[1]); w.w = cvt_pk_bf16(b[2], b[3]); return w; }

template <int K> __device__ __forceinline__ float swz_xor(float v) { return __int_as_float(__builtin_amdgcn_ds_swizzle(__float_as_int(v), 0x1f | (K << 10))); }
__device__ __forceinline__ float red32_add(float v) { auto rr = __builtin_amdgcn_permlane32_swap(__float_as_uint(v), __float_as_uint(v), false, false); return __uint_as_float(rr[0]) + __uint_as_float(rr[1]); }
__device__ __forceinline__ float red32_max(float v) { auto rr = __builtin_amdgcn_permlane32_swap(__float_as_uint(v), __float_as_uint(v), false, false); return fmaxf(__uint_as_float(rr[0]), __uint_as_float(rr[1])); }
__device__ __forceinline__ float red16_add(float v) { return v + swz_xor<16>(v); }
extern __shared__ __attribute__((aligned(16))) unsigned char lds_raw[];
constexpr int LDS_WIDTAB = 131072 + 12288 + 1024;
__device__ __forceinline__ int opaque_s(int v) { asm volatile("" : "+s"(v)); return v; }
__device__ __forceinline__ int hw_wave_key() { int k; asm volatile("s_getreg_b32 %0, hwreg(HW_REG_HW_ID, 0, 6)" : "=s"(k)); return k & 63; }
__device__ __forceinline__ int opaque_tid() {
    int lane; asm volatile("v_mbcnt_lo_u32_b32 %0, -1, 0\n\tv_mbcnt_hi_u32_b32 %0, -1, %0" : "=v"(lane));
    const int key = hw_wave_key();
    const int wid = __builtin_amdgcn_readfirstlane(*(volatile LAS int*)((LAS unsigned char*)lds_raw + LDS_WIDTAB + key * 4));
    return wid * 64 + lane;
}
namespace pg8 {
constexpr int BM = 256, BK = 64, HALF = 128, HTB = HALF * BK * 2, STAGE_BYTES = 8 * HTB, NXCD = 8, WGM = 8;
__host__ __device__ __forceinline__ int lds_byte(int r, int c) { const int st = (r >> 4) * 2 + (c >> 5), rr = r & 15, cc = c & 31, ob = rr * 64 + cc * 2; return st * 1024 + (ob ^ (((ob >> 9) & 1) << 5)); }
__host__ __device__ __forceinline__ void stage_rc(int b, int& R, int& C) { const int st = b / 1024, sb = b % 1024, swz = sb ^ (((sb >> 9) & 1) << 5); R = (st >> 1) * 16 + swz / 64; C = (st & 1) * 32 + (swz % 64) / 2; }
__host__ __device__ __forceinline__ int perm32(int rho) { const int n = rho >> 4, i = rho & 15; return 8 * (i >> 2) + 4 * n + (i & 3); }

struct Unit { int pm, pn; };
struct Gemm { const bf16_t* A; const bf16_t* Bt; int lda, ldb, K; };

struct StaticOrder {
    int nM, nN, nwg, G, c;
    __device__ void init(int M, int N, int G_, int c_) { nM = M / BM; nN = N / BM; nwg = nM * nN; G = G_; c = c_; }
    __device__ bool next(int i, Unit& u) const {
        const long L = (long)i * G + c; if (L >= nwg) return false;
        int wgid = (int)L; { const int q = nwg / NXCD, r = nwg % NXCD, xcd = wgid % NXCD, off = wgid / NXCD; wgid = (xcd < r ? xcd * (q + 1) : r * (q + 1) + (xcd - r) * q) + off; }
        const int nig = WGM * nN, gid = wgid / nig, fm = gid * WGM, gsz = (nM - fm) < WGM ? (nM - fm) : WGM;
        u.pm = fm + ((wgid % nig) % gsz); u.pn = (wgid % nig) / gsz; return true;
    }
};
struct S5StateOrder {
    int G, c;
    __device__ bool next(int i, Unit& u) const { const int L = i * G + c; if (L >= 256) return false; u.pm = L; u.pn = L >> 2; return true; }
};
struct S5OutOrder {
    int G, c;
    __device__ bool next(int i, Unit& u) const { const int L = i * G + c; if (L >= 512) return false; const int g = L >> 3, r = L & 7; u.pm = 4 * g + (r >> 1); u.pn = 2 * g + (r & 1); return true; }
};

template <class Epi, class Sched>
__device__ __forceinline__ void gemm_phase(LAS unsigned char* lds, const Gemm g, const Sched& S, const Epi& E) {
    const int tid = opaque_tid(), wid = __builtin_amdgcn_readfirstlane(tid >> 6), lane = tid & 63, wr = wid >> 2, wc = wid & 3, fr = lane & 15, fq = lane >> 4;
    const int K = g.K, nt = K / BK;
    unsigned voffA[2], voffB[2];
#pragma unroll
    for (int i = 0; i < 2; ++i) { int R, C; stage_rc(tid * 16 + i * 8192, R, C); const int Rb = Epi::PERM ? ((R & ~31) + perm32(R & 31)) : R;
        voffA[i] = (unsigned)(R * g.lda + C) * 2u; voffB[i] = (unsigned)(Rb * g.ldb + C) * 2u; }
    const size_t kstep = (size_t)(BK * 2);
    const size_t hA = (size_t)HALF * g.lda * 2, hB = (size_t)HALF * g.ldb * 2;
    const size_t tA = 2 * hA, tB = 2 * hB;
    const unsigned ldsw = (unsigned)wid * 1024u;
    const int aoff = lds_byte(wr * 64 + fr, fq * 8), boff = lds_byte(wc * 32 + fr, fq * 8);
#define PG8_SA(b, h) (((b) * 2 + (h)) * HTB)
#define PG8_SB(b, h) ((4 + (b) * 2 + (h)) * HTB)
#define PG8_STAGE(bufoff, gbase, voff) do { _Pragma("unroll") for (int _i = 0; _i < 2; ++_i) \
        __builtin_amdgcn_global_load_lds((const unsigned*)((const char*)(gbase) + (voff)[_i]), (LAS unsigned*)(lds + (bufoff) + ldsw + _i * 8192), 16, 0, 0); } while (0)
#define PG8_LDA(dst, b, h) do { _Pragma("unroll") for (int m = 0; m < 4; ++m) _Pragma("unroll") for (int k = 0; k < 2; ++k) dst[m][k] = *(const LAS bf16x8*)(lds + PG8_SA(b, h) + aoff + m * 2048 + k * 1024); } while (0)
#define PG8_LDB(dst, b, h) do { _Pragma("unroll") for (int n = 0; n < 2; ++n) _Pragma("unroll") for (int k = 0; k < 2; ++k) dst[n][k] = *(const LAS bf16x8*)(lds + PG8_SB(b, h) + boff + n * 2048 + k * 1024); } while (0)
#define PG8_MMA(ai, bj, At, Bt) do { __builtin_amdgcn_s_setprio(1); _Pragma("unroll") for (int m = 0; m < 4; ++m) _Pragma("unroll") for (int n = 0; n < 2; ++n) _Pragma("unroll") for (int k = 0; k < 2; ++k) \
        acc[ai][bj][m][n] = __builtin_amdgcn_mfma_f32_16x16x32_bf16(Bt[n][k], At[m][k], acc[ai][bj][m][n], 0, 0, 0); __builtin_amdgcn_s_setprio(0); } while (0)
#define PG8_WAIT_V(n) asm volatile("s_waitcnt vmcnt(" #n ")" ::: "memory")
#define PG8_WAIT_L(n) asm volatile("s_waitcnt lgkmcnt(" #n ")" ::: "memory")
#define PG8_BAR __builtin_amdgcn_s_barrier()
#define PG8_SCHED __builtin_amdgcn_sched_barrier(0)
    Unit cur, nxt; int ui = 0;
    if (!S.next(0, cur)) return;
    f32x4 acc[2][2][4][2];
#pragma unroll
    for (int a = 0; a < 2; ++a)
#pragma unroll
        for (int b = 0; b < 2; ++b)
#pragma unroll
            for (int m = 0; m < 4; ++m)
#pragma unroll
                for (int n = 0; n < 2; ++n) acc[a][b][m][n] = (f32x4){0.f, 0.f, 0.f, 0.f};
    bf16x8 At[4][2], B0[2][2], B1[2][2];
    const char* cA = (const char*)g.A + (size_t)cur.pm * tA; const char* cB = (const char*)g.Bt + (size_t)cur.pn * tB;
    PG8_STAGE(PG8_SB(0, 0), cB, voffB); PG8_STAGE(PG8_SB(0, 1), cB + hB, voffB); PG8_STAGE(PG8_SA(0, 0), cA, voffA); PG8_STAGE(PG8_SA(0, 1), cA + hA, voffA);
    if (wr == 1) PG8_BAR;
    PG8_WAIT_V(2); PG8_BAR;
    PG8_STAGE(PG8_SB(1, 0), cB + kstep, voffB); PG8_STAGE(PG8_SA(1, 0), cA + kstep, voffA); PG8_STAGE(PG8_SB(1, 1), cB + hB + kstep, voffB);
    PG8_WAIT_V(6); PG8_BAR;
    for (;;) {
        const bool has_next = S.next(ui + 1, nxt);
        const char* nA = has_next ? (const char*)g.A + (size_t)nxt.pm * tA : cA; const char* nB = has_next ? (const char*)g.Bt + (size_t)nxt.pn * tB : cB;
        for (int t = 0; t < nt; t += 2) {
            const bool last = (t == nt - 2);
            const char* a1 = cA + (size_t)(t + 1) * kstep;
            const char* a2 = last ? nA : cA + (size_t)(t + 2) * kstep; const char* b2 = last ? nB : cB + (size_t)(t + 2) * kstep;
            const char* a3 = a2 + kstep; const char* b3 = b2 + kstep;
            PG8_LDB(B0, 0, 0); PG8_LDB(B1, 0, 1); PG8_SCHED; PG8_LDA(At, 0, 0); PG8_STAGE(PG8_SA(1, 1), a1 + hA, voffA);
            PG8_WAIT_V(8); PG8_WAIT_L(0); PG8_BAR; PG8_MMA(0, 0, At, B0); PG8_MMA(0, 1, At, B1); PG8_BAR; PG8_SCHED;
            PG8_LDA(At, 0, 1); PG8_STAGE(PG8_SB(0, 0), b2, voffB); PG8_STAGE(PG8_SB(0, 1), b2 + hB, voffB); PG8_STAGE(PG8_SA(0, 0), a2, voffA);
            PG8_WAIT_V(8); PG8_WAIT_L(0); PG8_BAR; PG8_MMA(1, 0, At, B0); PG8_MMA(1, 1, At, B1); PG8_BAR; PG8_SCHED;
            PG8_LDB(B0, 1, 0); PG8_LDB(B1, 1, 1); PG8_SCHED; PG8_LDA(At, 1, 0); PG8_STAGE(PG8_SA(0, 1), a2 + hA, voffA);
            PG8_WAIT_V(8); PG8_WAIT_L(0); PG8_BAR; PG8_MMA(0, 0, At, B0); PG8_MMA(0, 1, At, B1); PG8_BAR; PG8_SCHED;
            PG8_LDA(At, 1, 1); PG8_STAGE(PG8_SB(1, 0), b3, voffB); PG8_STAGE(PG8_SB(1, 1), b3 + hB, voffB); PG8_STAGE(PG8_SA(1, 0), a3, voffA);
            PG8_WAIT_V(8); PG8_WAIT_L(0); PG8_BAR; PG8_MMA(1, 0, At, B0); PG8_MMA(1, 1, At, B1); PG8_BAR; PG8_SCHED;
        }
        if (wr == 0) PG8_BAR;
        E(acc, cur, ui, wr, wc, fr, fq);
        if (!has_next) break;
#pragma unroll
        for (int a = 0; a < 2; ++a)
#pragma unroll
            for (int b = 0; b < 2; ++b)
#pragma unroll
                for (int m = 0; m < 4; ++m)
#pragma unroll
                    for (int n = 0; n < 2; ++n) acc[a][b][m][n] = (f32x4){0.f, 0.f, 0.f, 0.f};
        cur = nxt; cA = nA; cB = nB; ++ui;
        if (wr == 1) PG8_BAR;
    }
    PG8_WAIT_V(0);
    PG8_BAR;
#undef PG8_SA
#undef PG8_SB
#undef PG8_STAGE
#undef PG8_LDA
#undef PG8_LDB
#undef PG8_MMA
#undef PG8_WAIT_V
#undef PG8_WAIT_L
#undef PG8_BAR
#undef PG8_SCHED
}

typedef f32x4 AccT[2][2][4][2];

struct EpiGateUp {
    static constexpr bool PERM = true;
    bf16_t* H; const LAS float* rs;
    __device__ __forceinline__ void operator()(const AccT& acc, const Unit& u, int ui, int wr, int wc, int fr, int fq) const {
        const int col0 = u.pn * 128 + wc * 32 + 8 * fq;
#pragma unroll
        for (int ai = 0; ai < 2; ++ai)
#pragma unroll
            for (int m = 0; m < 4; ++m) {
                const int rt = ai * 128 + wr * 64 + m * 16 + fr; const float r = rs[ui * 256 + rt];
                f32x4 hv[2];
#pragma unroll
                for (int n = 0; n < 2; ++n) { const f32x4 gv = acc[ai][0][m][n] * r, uv = acc[ai][1][m][n] * r;
#pragma unroll
                    for (int i = 0; i < 4; ++i) hv[n][i] = gv[i] * sigmoidf_(gv[i]) * uv[i]; }
                *(u32x4*)(H + (size_t)(u.pm * 256 + rt) * FF + col0) = pack8(hv[0], hv[1]);
            }
    }
};
struct EpiResAdd {
    static constexpr bool PERM = true;
    float* OUT; bf16_t* XB; float* SS; float scale;
    __device__ __forceinline__ void operator()(const AccT& acc, const Unit& u, int ui, int wr, int wc, int fr, int fq) const {
        const int col0 = u.pn * 256 + wc * 32 + 8 * fq;
#pragma unroll
        for (int ai = 0; ai < 2; ++ai) {
            u32x4 w[4][2];
#pragma unroll
            for (int m = 0; m < 4; ++m)
#pragma unroll
                for (int bj = 0; bj < 2; ++bj) w[m][bj] = *(const u32x4*)(XB + ((size_t)u.pm * 256 + ai * 128 + wr * 64 + m * 16 + fr) * DM + col0 + bj * 128);
#pragma unroll
            for (int m = 0; m < 4; ++m) {
                const size_t row = (size_t)u.pm * 256 + ai * 128 + wr * 64 + m * 16 + fr;
#pragma unroll
                for (int bj = 0; bj < 2; ++bj) {
                    const u32x4 ww = w[m][bj];
                    f32x4 a = (f32x4){bf_lo(ww.x), bf_hi(ww.x), bf_lo(ww.y), bf_hi(ww.y)}, b = (f32x4){bf_lo(ww.z), bf_hi(ww.z), bf_lo(ww.w), bf_hi(ww.w)};
                    a = a + acc[ai][bj][m][0] * scale; b = b + acc[ai][bj][m][1] * scale;
                    if (OUT) { float* op = OUT + row * DM + col0 + bj * 128; *(f32x4*)op = a; *(f32x4*)(op + 4) = b; }
                    else {
                        *(u32x4*)(XB + row * DM + col0 + bj * 128) = pack8(a, b);
                        float ss = (a[0] * a[0] + a[1] * a[1]) + (a[2] * a[2] + a[3] * a[3]) + (b[0] * b[0] + b[1] * b[1]) + (b[2] * b[2] + b[3] * b[3]);
                        ss = red16_add(ss); ss = red32_add(ss);
                        if (fq == 0) SS[row * 32 + u.pn * 8 + bj * 4 + wc] = ss;
                    }
                }
            }
        }
    }
};
struct EpiGlu {
    static constexpr bool PERM = true;
    bf16_t* XB; float* SS;
    __device__ __forceinline__ void operator()(const AccT& acc, const Unit& u, int ui, int wr, int wc, int fr, int fq) const {
        const int col0 = u.pn * 128 + wc * 32 + 8 * fq;
        u32x4 w[2][4];
#pragma unroll
        for (int ai = 0; ai < 2; ++ai)
#pragma unroll
            for (int m = 0; m < 4; ++m) w[ai][m] = *(const u32x4*)(XB + ((size_t)u.pm * 256 + ai * 128 + wr * 64 + m * 16 + fr) * DM + col0);
#pragma unroll
        for (int ai = 0; ai < 2; ++ai)
#pragma unroll
            for (int m = 0; m < 4; ++m) {
                const size_t row = (size_t)u.pm * 256 + ai * 128 + wr * 64 + m * 16 + fr;
                const u32x4 ww = w[ai][m];
                f32x4 a = (f32x4){bf_lo(ww.x), bf_hi(ww.x), bf_lo(ww.y), bf_hi(ww.y)}, b = (f32x4){bf_lo(ww.z), bf_hi(ww.z), bf_lo(ww.w), bf_hi(ww.w)};
#pragma unroll
                for (int i = 0; i < 4; ++i) { a[i] += acc[ai][0][m][0][i] * sigmoidf_(acc[ai][1][m][0][i]); b[i] += acc[ai][0][m][1][i] * sigmoidf_(acc[ai][1][m][1][i]); }
                *(u32x4*)(XB + row * DM + col0) = pack8(a, b);
                float ss = (a[0] * a[0] + a[1] * a[1]) + (a[2] * a[2] + a[3] * a[3]) + (b[0] * b[0] + b[1] * b[1]) + (b[2] * b[2] + b[3] * b[3]);
                ss = red16_add(ss); ss = red32_add(ss);
                if (fq == 0) SS[row * 32 + u.pn * 4 + wc] = ss;
            }
    }
};
struct EpiInProj {
    static constexpr bool PERM = true;
    bf16_t* QKV; float* LF; const LAS float* rs; const LAS float* gt; const float* fgb;
    __device__ __forceinline__ void operator()(const AccT& acc, const Unit& u, int ui, int wr, int wc, int fr, int fq) const {
        if (u.pn == 12) {
            if (wc == 0 && fq == 0) {
                const f32x4 b0 = *(const f32x4*)fgb, b1 = *(const f32x4*)(fgb + 4);
#pragma unroll
                for (int ai = 0; ai < 2; ++ai)
#pragma unroll
                    for (int m = 0; m < 4; ++m) {
                        const int rt = ai * 128 + wr * 64 + m * 16 + fr; const float r = rs[ui * 256 + rt];
                        f32x4 z0 = acc[ai][0][m][0] * r + b0, z1 = acc[ai][0][m][1] * r + b1;
#pragma unroll
                        for (int i = 0; i < 4; ++i) { z0[i] = fminf(z0[i], 0.f) - log1pf(__expf(-fabsf(z0[i]))); z1[i] = fminf(z1[i], 0.f) - log1pf(__expf(-fabsf(z1[i]))); }
                        float* lp = LF + (size_t)(u.pm * 256 + rt) * 8; *(f32x4*)lp = z0; *(f32x4*)(lp + 4) = z1;
                    }
            }
            return;
        }
        const int sl = 4 * u.pn + wc, region = sl >> 3, within = sl & 7, kind = region % 3;
        const int colbase = (region >= 3 ? 512 : 0) + within * 64 + 8 * fq;
        bf16_t* dst = QKV + (size_t)kind * ((size_t)MTOK * DM);
        const int gsel = (region >= 3 ? 2 : 0) + (kind == 1 ? 1 : 0);
        f32x4 gn[2][2];
#pragma unroll
        for (int bj = 0; bj < 2; ++bj)
#pragma unroll
            for (int n = 0; n < 2; ++n) gn[bj][n] = *(const LAS f32x4*)(gt + gsel * 64 + 32 * bj + 8 * fq + 4 * n);
        const bool isv = (kind == 2);
        const float qs = kind == 0 ? QSCALE : 1.0f;
#pragma unroll
        for (int ai = 0; ai < 2; ++ai)
#pragma unroll
            for (int m = 0; m < 4; ++m) {
                const int rt = ai * 128 + wr * 64 + m * 16 + fr; const float r = rs[ui * 256 + rt];
                f32x4 v[2][2]; float ss = 0.f;
#pragma unroll
                for (int bj = 0; bj < 2; ++bj)
#pragma unroll
                    for (int n = 0; n < 2; ++n) { v[bj][n] = acc[ai][bj][m][n] * r; const f32x4 x = v[bj][n]; ss += (x[0] * x[0] + x[1] * x[1]) + (x[2] * x[2] + x[3] * x[3]); }
                ss = red16_add(ss); ss = red32_add(ss);
                const float rn = isv ? 1.0f : rsqrtf(ss * (1.0f / 64.0f) + EPS) * qs;
                bf16_t* rowp = dst + (size_t)(u.pm * 256 + rt) * DM + colbase;
#pragma unroll
                for (int bj = 0; bj < 2; ++bj) { f32x4 x0 = v[bj][0] * rn, x1 = v[bj][1] * rn; if (!isv) { x0 = x0 * gn[bj][0]; x1 = x1 * gn[bj][1]; } *(u32x4*)(rowp + 32 * bj) = pack8(x0, x1); }
            }
    }
};
struct EpiS5State {
    static constexpr bool PERM = true;
    float* SST;
    __device__ __forceinline__ void operator()(const AccT& acc, const Unit& u, int ui, int wr, int wc, int fr, int fq) const {
#pragma unroll
        for (int ai = 0; ai < 2; ++ai)
#pragma unroll
            for (int m = 0; m < 4; ++m) {
                const size_t row = (size_t)u.pm * 256 + ai * 128 + wr * 64 + m * 16 + fr;
                float* p = SST + row * 128 + wc * 32 + 8 * fq;
                *(f32x4*)p = acc[ai][0][m][0]; *(f32x4*)(p + 4) = acc[ai][0][m][1];
            }
    }
};
struct EpiS5Out {
    static constexpr bool PERM = true;
    const bf16_t* UA; const float* dsk; bf16_t* Y;
    __device__ __forceinline__ void operator()(const AccT& acc, const Unit& u, int ui, int wr, int wc, int fr, int fq) const {
        const int g = u.pm >> 2;
        f32x4 dv[2][2];
#pragma unroll
        for (int bj = 0; bj < 2; ++bj) { const int c0 = ((u.pn & 1) * 256 + bj * 128 + wc * 32 + 8 * fq) & 15; dv[bj][0] = *(const f32x4*)(dsk + g * 16 + c0); dv[bj][1] = *(const f32x4*)(dsk + g * 16 + c0 + 4); }
#pragma unroll
        for (int ai = 0; ai < 2; ++ai) {
            u32x4 uw[4][2];
#pragma unroll
            for (int m = 0; m < 4; ++m)
#pragma unroll
                for (int bj = 0; bj < 2; ++bj) uw[m][bj] = *(const u32x4*)(UA + (size_t)(u.pm * 256 + ai * 128 + wr * 64 + m * 16 + fr) * 640 + (u.pn & 1) * 256 + bj * 128 + wc * 32 + 8 * fq);
#pragma unroll
            for (int m = 0; m < 4; ++m) {
                const int row = u.pm * 256 + ai * 128 + wr * 64 + m * 16 + fr;
                const int n_ = row & 1023, b = n_ >> 7, k = n_ & 127;
#pragma unroll
                for (int bj = 0; bj < 2; ++bj) {
                    const int col8 = (u.pn & 1) * 256 + bj * 128 + wc * 32 + 8 * fq, t = col8 >> 4, c0 = col8 & 15;
                    const u32x4 w = uw[m][bj]; const f32x4 d0 = dv[bj][0], d1 = dv[bj][1];
                    f32x4 y0, y1;
                    y0[0] = acc[ai][bj][m][0][0] + d0[0] * bf_lo(w.x); y0[1] = acc[ai][bj][m][0][1] + d0[1] * bf_hi(w.x);
                    y0[2] = acc[ai][bj][m][0][2] + d0[2] * bf_lo(w.y); y0[3] = acc[ai][bj][m][0][3] + d0[3] * bf_hi(w.y);
                    y1[0] = acc[ai][bj][m][1][0] + d1[0] * bf_lo(w.z); y1[1] = acc[ai][bj][m][1][1] + d1[1] * bf_hi(w.z);
                    y1[2] = acc[ai][bj][m][1][2] + d1[2] * bf_lo(w.w); y1[3] = acc[ai][bj][m][1][3] + d1[3] * bf_hi(w.w);
#pragma unroll
                    for (int i = 0; i < 4; ++i) { y0[i] = gelu_tanh(y0[i]); y1[i] = gelu_tanh(y1[i]); }
                    *(u32x4*)(Y + ((size_t)b * SEQ + k * 32 + t) * DM + g * 16 + c0) = pack8(y0, y1);
                }
            }
        }
    }
};
}

struct Args { const float* in[33]; float* out; unsigned char* ws; };
typedef const __attribute__((address_space(4))) Args* ArgsP;
__device__ __forceinline__ ArgsP kargs() { ArgsP p = (ArgsP)__builtin_amdgcn_kernarg_segment_ptr(); asm volatile("" : "+s"(p)); return p; }

__device__ __forceinline__ float wave_sum(float v) {
    v += swz_xor<1>(v); v += swz_xor<2>(v); v += swz_xor<4>(v); v += swz_xor<8>(v); v += swz_xor<16>(v);
    return red32_add(v);
}

template <class Sched>
__device__ __forceinline__ void compute_rowscale(const Sched& S, const float* SS, LAS float* rs) {
    const int t = opaque_tid(), row = t >> 1, half = t & 1;
    pg8::Unit u;
    for (int ui = 0; S.next(ui, u); ++ui) {
        const float* p = SS + ((size_t)u.pm * 256 + row) * 32 + half * 16;
        const f32x4 a = *(const f32x4*)p, b = *(const f32x4*)(p + 4), c = *(const f32x4*)(p + 8), d = *(const f32x4*)(p + 12);
        float s = ((a[0] + a[1]) + (a[2] + a[3])) + ((b[0] + b[1]) + (b[2] + b[3])) + ((c[0] + c[1]) + (c[2] + c[3])) + ((d[0] + d[1]) + (d[2] + d[3]));
        s += swz_xor<1>(s);
        if (half == 0) rs[ui * 256 + row] = rsqrtf(s * (1.0f / 1024.0f) + EPS);
    }
    __syncthreads();
}

__device__ __forceinline__ void transpose_item(const float* W, int K, int srcN, int c0, int nvalid, const float* gain, bf16_t* WT, int n0, int k0, LAS float* scr, int lane) {
    const int cc = (lane & 7) * 4, r0 = lane >> 3;
    f32x4 v[8];
#pragma unroll
    for (int i = 0; i < 8; ++i) { const int kk = r0 + 8 * i; v[i] = (cc < nvalid) ? *(const f32x4*)(W + (size_t)(k0 + kk) * srcN + c0 + cc) : (f32x4){0.f, 0.f, 0.f, 0.f}; }
#pragma unroll
    for (int i = 0; i < 8; ++i) { const int kk = r0 + 8 * i; const float g = gain ? gain[k0 + kk] : 1.0f;
        LAS float* d = scr + kk * 33 + cc; d[0] = v[i][0] * g; d[1] = v[i][1] * g; d[2] = v[i][2] * g; d[3] = v[i][3] * g; }
    asm volatile("s_waitcnt lgkmcnt(0)" ::: "memory");
    const int c = lane & 7;
#pragma unroll
    for (int j = 0; j < 4; ++j) { const int n = (lane >> 3) + 8 * j; const LAS float* s = scr + (8 * c) * 33 + n;
        u32x4 o; o.x = cvt_pk_bf16(s[0 * 33], s[1 * 33]); o.y = cvt_pk_bf16(s[2 * 33], s[3 * 33]); o.z = cvt_pk_bf16(s[4 * 33], s[5 * 33]); o.w = cvt_pk_bf16(s[6 * 33], s[7 * 33]);
        *(u32x4*)(WT + (size_t)(n0 + n) * K + k0 + 8 * c) = o; }
    asm volatile("s_waitcnt lgkmcnt(0)" ::: "memory");
}

__device__ __forceinline__ void convert_item(ArgsP a, int it, LAS float* scr, int lane) {
    unsigned char* ws = a->ws;
    if (it < 8 * 2816) {
        const int mi = it / 2816, r = it % 2816, l = mi >> 1, f = mi & 1;
        const int nblk = 5632 / 32, kb = r / nblk, nb = r % nblk, n0 = 32 * nb, pn = n0 >> 8, tc = n0 & 255, bj = tc >> 7, j = tc & 127;
        const float* W = (bj ? a->in[f ? 8 : 3] : a->in[f ? 7 : 2]) + (size_t)l * DM * FF;
        const float* gain = a->in[f ? 6 : 1] + l * DM;
        transpose_item(W, DM, FF, 128 * pn + j, 32, gain, (bf16_t*)(ws + WS_WGU + (size_t)mi * WGU_SZ), n0, 64 * kb, scr, lane);
        return;
    }
    it -= 8 * 2816;
    if (it < 8 * 1408) {
        const int mi = it / 1408, r = it % 1408, l = mi >> 1, f = mi & 1;
        const int nblk = 32, kb = r / nblk, nb = r % nblk;
        const float* W = a->in[f ? 9 : 4] + (size_t)l * FF * DM;
        transpose_item(W, FF, DM, 32 * nb, 32, nullptr, (bf16_t*)(ws + WS_WDN + (size_t)mi * WDN_SZ), 32 * nb, 64 * kb, scr, lane);
        return;
    }
    it -= 8 * 1408;
    const int j = it / 3200; int r = it % 3200;
    if (r < 1664) {
        const int nblk = 104, kb = r / nblk, nb = r % nblk, n0 = 32 * nb, pn = n0 >> 8, tc = n0 & 255;
        int c0, nvalid;
        if (pn < 12) { const int bj = tc >> 7, wc = (tc & 127) >> 5; c0 = (4 * pn + wc) * 64 + 32 * bj; nvalid = 32; }
        else { c0 = 3072; nvalid = (tc == 0) ? 8 : 0; }
        transpose_item(a->in[10] + (size_t)j * DM * 3080, DM, 3080, c0, nvalid, a->in[5] + (2 * j) * DM, (bf16_t*)(ws + WS_WIN + (size_t)j * WIN_SZ), n0, 64 * kb, scr, lane);
        return;
    }
    r -= 1664;
    if (r < 512) {
        const int nblk = 32, kb = r / nblk, nb = r % nblk;
        transpose_item(a->in[11] + (size_t)j * DM * DM, DM, DM, 32 * nb, 32, nullptr, (bf16_t*)(ws + WS_WOUT + (size_t)j * WOUT_SZ), 32 * nb, 64 * kb, scr, lane);
        return;
    }
    r -= 512;
    {
        const int nblk = 64, kb = r / nblk, nb = r % nblk, n0 = 32 * nb, pn = n0 >> 8, tc = n0 & 255, bj = tc >> 7, jj = tc & 127;
        const float* W = a->in[bj ? 32 : 31] + (size_t)j * DM * DM;
        transpose_item(W, DM, DM, 128 * pn + jj, 32, nullptr, (bf16_t*)(ws + WS_WGLU + (size_t)j * WGLU_SZ), n0, 64 * kb, scr, lane);
    }
}
constexpr int N_CONVERT_ITEMS = 8 * 2816 + 8 * 1408 + 2 * 3200;

__device__ void s5_setup(ArgsP a, int j, int g, int part, LAS unsigned char* lds) {
    const int tid = opaque_tid();
    LAS float* lamp = (LAS float*)lds;
    LAS float* bbar = lamp + 64 * 33 * 2;
    LAS float* cc = bbar + 64 * 16 * 2;
    LAS float* Kt = cc + 16 * 64 * 2;
    const float step = __expf(a->in[25][j * 64 + g]);
    const float* are = a->in[23] + (size_t)(j * 64 + g) * 64; const float* aim = a->in[24] + (size_t)(j * 64 + g) * 64;
    for (int idx = tid; idx < 64 * 33; idx += 512) { const int p = idx / 33, k = idx % 33;
        const float mag = expf((float)k * are[p] * step), ang = (float)k * aim[p] * step; float sn, cs; sincosf(ang, &sn, &cs);
        lamp[idx * 2] = mag * cs; lamp[idx * 2 + 1] = mag * sn; }
    for (int idx = tid; idx < 1024; idx += 512) { const int p = idx >> 4, c = idx & 15;
        const float ar = are[p], ai = aim[p]; const float mag = expf(ar * step); float sn, cs; sincosf(ai * step, &sn, &cs);
        const float lr = mag * cs, li = mag * sn, den = ar * ar + ai * ai;
        const float cr = ((lr - 1.0f) * ar + li * ai) / den, ci = (li * ar - (lr - 1.0f) * ai) / den;
        const float br = a->in[26][((size_t)(j * 64 + g) * 64 + p) * 16 + c], bi = a->in[27][((size_t)(j * 64 + g) * 64 + p) * 16 + c];
        bbar[idx * 2] = cr * br - ci * bi; bbar[idx * 2 + 1] = cr * bi + ci * br;
        const int c2 = idx >> 6, p2 = idx & 63;
        cc[idx * 2] = a->in[28][((size_t)(j * 64 + g) * 16 + c2) * 64 + p2]; cc[idx * 2 + 1] = a->in[29][((size_t)(j * 64 + g) * 16 + c2) * 64 + p2]; }
    __syncthreads();
    {
        const int tau = tid >> 4, c = tid & 15;
        float acc[16];
#pragma unroll
        for (int i = 0; i < 16; ++i) acc[i] = 0.f;
        for (int p = 0; p < 64; ++p) {
            const float cr = cc[(c * 64 + p) * 2], ci = cc[(c * 64 + p) * 2 + 1], lr = lamp[(p * 33 + tau) * 2], li = lamp[(p * 33 + tau) * 2 + 1];
            const float zr = cr * lr - ci * li, zi = cr * li + ci * lr;
#pragma unroll
            for (int i = 0; i < 16; ++i) acc[i] += zr * bbar[(p * 16 + i) * 2] - zi * bbar[(p * 16 + i) * 2 + 1];
        }
#pragma unroll
        for (int i = 0; i < 16; ++i) Kt[tau * 260 + c * 16 + i] = acc[i];
    }
    __syncthreads();
    bf16_t* W1 = (bf16_t*)(a->ws + WS_S5W1) + (size_t)g * 256 * 512;
    for (int ch = tid + 512 * part; ch < 256 * 64; ch += 512 * 3) {
        const int row = ch >> 6, c8 = ch & 63; float v[8];
        if (row < 128) { const int p = row & 63, s = c8 >> 1, c0 = (c8 & 1) * 8; const float lr = lamp[(p * 33 + 31 - s) * 2], li = lamp[(p * 33 + 31 - s) * 2 + 1];
#pragma unroll
            for (int i = 0; i < 8; ++i) { const float br = bbar[(p * 16 + c0 + i) * 2], bi = bbar[(p * 16 + c0 + i) * 2 + 1]; v[i] = row < 64 ? (lr * br - li * bi) : (lr * bi + li * br); } }
        else {
#pragma unroll
            for (int i = 0; i < 8; ++i) v[i] = 0.f; }
        u32x4 o; o.x = cvt_pk_bf16(v[0], v[1]); o.y = cvt_pk_bf16(v[2], v[3]); o.z = cvt_pk_bf16(v[4], v[5]); o.w = cvt_pk_bf16(v[6], v[7]);
        *(u32x4*)(W1 + (size_t)row * 512 + c8 * 8) = o;
    }
    bf16_t* WA = (bf16_t*)(a->ws + WS_S5WA) + (size_t)g * 512 * 640;
    for (int ch = tid + 512 * part; ch < 512 * 80; ch += 512 * 3) {
        const int row = ch / 80, c8 = ch % 80, t = row >> 4, c = row & 15; float v[8];
        if (c8 < 64) { const int s = c8 >> 1, c0 = (c8 & 1) * 8;
#pragma unroll
            for (int i = 0; i < 8; ++i) v[i] = (s <= t) ? Kt[(t - s) * 260 + c * 16 + c0 + i] : 0.f; }
        else { const int pb = (c8 - 64) * 8;
#pragma unroll
            for (int i = 0; i < 8; ++i) { const int pp = pb + i, p = pp & 63; const float cr = cc[(c * 64 + p) * 2], ci = cc[(c * 64 + p) * 2 + 1], lr = lamp[(p * 33 + t + 1) * 2], li = lamp[(p * 33 + t + 1) * 2 + 1];
                v[i] = pp < 64 ? (cr * lr - ci * li) : -(cr * li + ci * lr); } }
        u32x4 o; o.x = cvt_pk_bf16(v[0], v[1]); o.y = cvt_pk_bf16(v[2], v[3]); o.z = cvt_pk_bf16(v[4], v[5]); o.w = cvt_pk_bf16(v[6], v[7]);
        *(u32x4*)(WA + (size_t)row * 640 + c8 * 8) = o;
    }
    __syncthreads();
}

__device__ void s5_build_u(ArgsP a, int layer, LAS unsigned char* lds) {
    const int tid = opaque_tid(), lane = tid & 63, wid = tid >> 6;
    const bf16_t* XB = (const bf16_t*)(a->ws + WS_XB); const float* SS = (const float*)(a->ws + WS_SS);
    bf16_t* UA = (bf16_t*)(a->ws + WS_R + R_UA);
    const float* gain = a->in[5] + layer * DM;
    LAS float* rsl = (LAS float*)(lds + 32 * 2064);
    for (int n = blockIdx.x; n < 1024; n += gridDim.x) {
        const size_t tok0 = (size_t)(n >> 7) * SEQ + (size_t)(n & 127) * 32;
        if (tid < 256) { const int row = tid >> 3, part = tid & 7; const f32x4 v = *(const f32x4*)(SS + (tok0 + row) * 32 + part * 4);
            float s = (v[0] + v[1]) + (v[2] + v[3]); s += swz_xor<1>(s); s += swz_xor<2>(s); s += swz_xor<4>(s);
            if (part == 0) rsl[row] = rsqrtf(s * (1.0f / 1024.0f) + EPS); }
        __syncthreads();
#pragma unroll
        for (int i = 0; i < 8; ++i) { const int id = i * 512 + tid, row = id >> 7, c16 = id & 127;
            const u32x4 w = *(const u32x4*)(XB + (tok0 + row) * DM + c16 * 8); const float r = rsl[row];
            const f32x4 g0 = *(const f32x4*)(gain + c16 * 8), g1 = *(const f32x4*)(gain + c16 * 8 + 4);
            u32x4 o; o.x = cvt_pk_bf16(bf_lo(w.x) * r * g0[0], bf_hi(w.x) * r * g0[1]); o.y = cvt_pk_bf16(bf_lo(w.y) * r * g0[2], bf_hi(w.y) * r * g0[3]);
            o.z = cvt_pk_bf16(bf_lo(w.z) * r * g1[0], bf_hi(w.z) * r * g1[1]); o.w = cvt_pk_bf16(bf_lo(w.w) * r * g1[2], bf_hi(w.w) * r * g1[3]);
            *(LAS u32x4*)(lds + row * 2064 + c16 * 16) = o; }
        __syncthreads();
#pragma unroll
        for (int gg = 0; gg < 8; ++gg) { const int g = wid * 8 + gg, s = lane >> 1, half = lane & 1;
            const u32x4 v = *(const LAS u32x4*)(lds + s * 2064 + g * 32 + half * 16);
            *(u32x4*)(UA + ((size_t)g * 1024 + n) * 640 + lane * 8) = v; }
        __syncthreads();
    }
}

__device__ void s5_scan(ArgsP a, int j) {
    const int gt = blockIdx.x * 512 + opaque_tid();
    if (gt >= 32768) return;
    const int p = gt & 63, g = (gt >> 6) & 63, b = gt >> 12;
    const float step = __expf(a->in[25][j * 64 + g]);
    const float ar = a->in[23][(size_t)(j * 64 + g) * 64 + p], ai = a->in[24][(size_t)(j * 64 + g) * 64 + p];
    const float mag = expf(32.0f * ar * step); float sn, cs; sincosf(32.0f * ai * step, &sn, &cs);
    const float lr = mag * cs, li = mag * sn;
    const float* SST = (const float*)(a->ws + WS_R + R_SST) + ((size_t)g * 1024 + b * 128) * 128;
    bf16_t* UA = (bf16_t*)(a->ws + WS_R + R_UA) + ((size_t)g * 1024 + b * 128) * 640 + 512;
    float xr = 0.f, xi = 0.f;
    for (int k0 = 0; k0 < 128; k0 += 16) {
        float sr[16], si[16];
#pragma unroll
        for (int i = 0; i < 16; ++i) { sr[i] = SST[(size_t)(k0 + i) * 128 + p]; si[i] = SST[(size_t)(k0 + i) * 128 + 64 + p]; }
#pragma unroll
        for (int i = 0; i < 16; ++i) {
            UA[(size_t)(k0 + i) * 640 + p] = (bf16_t)(cvt_pk_bf16(xr, 0.f) & 0xffffu); UA[(size_t)(k0 + i) * 640 + 64 + p] = (bf16_t)(cvt_pk_bf16(xi, 0.f) & 0xffffu);
            const float nr = lr * xr - li * xi + sr[i], ni = lr * xi + li * xr + si[i]; xr = nr; xi = ni;
        }
    }
}

__device__ void cumsum_bh(ArgsP a, int bh, LAS unsigned char* lds) {
    const int tid = opaque_tid(), lane = tid & 63, wid = tid >> 6, b = bh >> 3, h = bh & 7;
    const float* LF = (const float*)(a->ws + WS_LF) + ((size_t)b * SEQ + tid * 8) * 8 + h;
    float v[8]; float run = 0.f;
#pragma unroll
    for (int i = 0; i < 8; ++i) { run += LF[i * 8]; v[i] = run; }
    LAS float* tot = (LAS float*)lds;
    tot[tid] = run;
    __syncthreads();
    float off = 0.f;
    for (int u = 0; u < tid; ++u) off += tot[u];
    float* C = (float*)(a->ws + WS_CUM) + (size_t)bh * SEQ + tid * 8;
#pragma unroll
    for (int i = 0; i < 8; ++i) C[i] = (off + v[i]) * LOG2E;
    __syncthreads();
}

__device__ __forceinline__ int crow(int r, int hi) { return (r & 3) + 8 * (r >> 2) + 4 * hi; }
__device__ __forceinline__ void glds16(const void* g, LAS void* l) { __builtin_amdgcn_global_load_lds((const unsigned*)g, (LAS unsigned*)l, 16, 0, 0); }
__device__ __forceinline__ void glds4(const void* g, LAS void* l) { __builtin_amdgcn_global_load_lds((const unsigned*)g, (LAS unsigned*)l, 4, 0, 0); }
__device__ __forceinline__ s16x4 vtr(const LAS char* p) { return __builtin_bit_cast(s16x4, __builtin_amdgcn_ds_read_tr16_b64_v4i16((LAS s16x4*)p)); }

constexpr int AT_STAGE = 32768, AT_CK = 65536, AT_TB = 66048, AT_WSF = 66560, AT_XCH = 68608, AT_MISC = 69632;

struct AttnP { const bf16_t *Q, *K, *V; bf16_t* O; const float* cum; const float* relb; const float* subg; float lam, lam_init, ref_fox, ref_diff; };

template <int NMAP>
__device__ __forceinline__ void attn_unit(LAS unsigned char* lds, const AttnP& P, int b, int h, int qb) {
    const int tid = opaque_tid(), lane = tid & 63, r32 = lane & 31, hi = lane >> 5, wid = __builtin_amdgcn_readfirstlane(tid >> 6);
    constexpr int QROWS = NMAP == 1 ? 256 : 128, ND = NMAP == 1 ? 2 : 4;
    const int q0 = qb * QROWS;
    const int rb = NMAP == 1 ? wid : (wid >> 1), mp = NMAP == 1 ? 0 : (wid & 1);
    const int qw0 = q0 + rb * 32;
    const size_t rowbase = (size_t)b * SEQ;
    const int colqk = NMAP == 1 ? 512 + h * 64 : h * 128;
    const int NT = (q0 + QROWS) >> 6, tl = (qw0 + 31) >> 6;
    const int bh = b * 8 + h;
    LAS float* tb = (LAS float*)(lds + AT_TB);

    float cbase;
    if (NMAP == 2) {
        if (tid < 128) {
            int bk = tid; if (tid >= 16) { bk = 16 + (int)(logf((float)tid * (1.0f / 16.0f)) / 2.0794415416798357f * 16.0f); bk = bk < 31 ? bk : 31; }
            tb[tid] = (P.relb[bk * 4 + h] - P.relb[31 * 4 + h]) * LOG2E;
        }
        float bm = (lane < 32) ? (P.relb[lane * 4 + h] - P.relb[31 * 4 + h]) * LOG2E : 0.f;
        bm = fmaxf(bm, swz_xor<1>(bm)); bm = fmaxf(bm, swz_xor<2>(bm)); bm = fmaxf(bm, swz_xor<4>(bm)); bm = fmaxf(bm, swz_xor<8>(bm)); bm = fmaxf(bm, swz_xor<16>(bm)); bm = red32_max(bm);
        cbase = -(P.ref_diff + bm);
    } else {
        cbase = P.cum[(size_t)bh * SEQ + qw0 + r32] - P.ref_fox;
    }
    bf16x8 qr[4];
#pragma unroll
    for (int d0 = 0; d0 < 4; ++d0) qr[d0] = *(const bf16x8*)(P.Q + (rowbase + qw0 + r32) * DM + colqk + mp * 64 + d0 * 16 + hi * 8);

    auto issue = [&](int t, int st) {
        LAS unsigned char* sb = lds + st * AT_STAGE;
        const bf16_t* kp = P.K + (rowbase + 64 * t + lane) * DM + colqk + wid * 8;
#pragma unroll
        for (int m = 0; m < NMAP; ++m) glds16(kp + m * 64, sb + m * 8192 + wid * 1024);
#pragma unroll
        for (int q = 0; q < NMAP; ++q) { const int pp = wid + 8 * q, dblk = pp >> 2, kvb = pp & 3;
            glds16(P.V + (rowbase + 64 * t + 16 * kvb + (lane >> 2)) * DM + colqk + dblk * 32 + (lane & 3) * 8, sb + 16384 + pp * 1024); }
    };

    f32x16 o[ND], ol = f32x16{}; float lsum = 0.f;
#pragma unroll
    for (int d = 0; d < ND; ++d) o[d] = f32x16{};
    const bf16x8 ones = (bf16x8){0x3f80, 0x3f80, 0x3f80, 0x3f80, 0x3f80, 0x3f80, 0x3f80, 0x3f80};

    issue(0, 0);
    const float* cumrow = P.cum + (size_t)bh * SEQ + lane;
    float ckn = 0.f;
    if (NMAP == 1 && wid == 0) ((LAS float*)(lds + AT_CK))[lane] = cumrow[0];
    for (int t = 0; t < NT; ++t) {
        const int st = t & 1;
        asm volatile("s_waitcnt vmcnt(0)" ::: "memory");
        __syncthreads();
        if (t + 1 < NT) { issue(t + 1, st ^ 1); if (NMAP == 1 && wid == 0) ckn = cumrow[64 * (t + 1)]; }
        if (t <= tl) {
            const LAS char* sb = (const LAS char*)(lds + st * AT_STAGE);
            f32x16 p[2];
            if (NMAP == 1) {
                const LAS float* ck = (const LAS float*)(lds + AT_CK + st * 256);
                const f32x4 c0 = *(const LAS f32x4*)(ck + 4 * hi), c1 = *(const LAS f32x4*)(ck + 4 * hi + 8), c2 = *(const LAS f32x4*)(ck + 4 * hi + 16), c3 = *(const LAS f32x4*)(ck + 4 * hi + 24);
                const f32x4 c4 = *(const LAS f32x4*)(ck + 4 * hi + 32), c5 = *(const LAS f32x4*)(ck + 4 * hi + 40), c6 = *(const LAS f32x4*)(ck + 4 * hi + 48), c7 = *(const LAS f32x4*)(ck + 4 * hi + 56);
                const f32x16 k0 = (f32x16){c0[0], c0[1], c0[2], c0[3], c1[0], c1[1], c1[2], c1[3], c2[0], c2[1], c2[2], c2[3], c3[0], c3[1], c3[2], c3[3]};
                const f32x16 k1 = (f32x16){c4[0], c4[1], c4[2], c4[3], c5[0], c5[1], c5[2], c5[3], c6[0], c6[1], c6[2], c6[3], c7[0], c7[1], c7[2], c7[3]};
                p[0] = cbase - k0; p[1] = cbase - k1;
            } else {
#pragma unroll
                for (int r = 0; r < 16; ++r) { p[0][r] = cbase; p[1][r] = cbase; }
            }
            { const LAS char* kb = sb + mp * 8192 + hi * 1024 + r32 * 16;
#pragma unroll
              for (int d0 = 0; d0 < 4; ++d0) { const bf16x8 b0 = *(const LAS bf16x8*)(kb + d0 * 2048), b1 = *(const LAS bf16x8*)(kb + d0 * 2048 + 512);
                  p[0] = __builtin_amdgcn_mfma_f32_32x32x16_bf16(b0, qr[d0], p[0], 0, 0, 0); p[1] = __builtin_amdgcn_mfma_f32_32x32x16_bf16(b1, qr[d0], p[1], 0, 0, 0); } }
            const int qd = qw0 + r32 - 64 * t - 4 * hi;
            if (NMAP == 2 && (64 * t + 63 + 113 > qw0)) {
                asm volatile("" ::: "memory");
#pragma unroll
                for (int j = 0; j < 8; ++j)
#pragma unroll
                    for (int i = 0; i < 4; ++i) { int n = qd - 8 * j - i; n = n < 0 ? 0 : (n > 127 ? 127 : n); p[j >> 2][4 * (j & 3) + i] += tb[n]; }
            }
            if (64 * t + 63 > qw0) {
                asm volatile("" ::: "memory");
#pragma unroll
                for (int j = 0; j < 8; ++j)
#pragma unroll
                    for (int i = 0; i < 4; ++i) if (8 * j + i > qd) p[j >> 2][4 * (j & 3) + i] = -INFINITY;
            }
#pragma unroll
            for (int r = 0; r < 16; ++r) { p[0][r] = fast_exp2(p[0][r]); p[1][r] = fast_exp2(p[1][r]); }
            if (NMAP == 2) { const f32x16 sv = p[0] + p[1];
                lsum += ((sv[0] + sv[1]) + (sv[2] + sv[3])) + ((sv[4] + sv[5]) + (sv[6] + sv[7])) + ((sv[8] + sv[9]) + (sv[10] + sv[11])) + ((sv[12] + sv[13]) + (sv[14] + sv[15])); }
            bf16x8 pw[4];
#pragma unroll
            for (int ks = 0; ks < 4; ++ks) { const int hp = ks >> 1, bs = 8 * (ks & 1);
                u32x4 w; w.x = cvt_pk_bf16(p[hp][bs + 0], p[hp][bs + 1]); w.y = cvt_pk_bf16(p[hp][bs + 2], p[hp][bs + 3]); w.z = cvt_pk_bf16(p[hp][bs + 4], p[hp][bs + 5]); w.w = cvt_pk_bf16(p[hp][bs + 6], p[hp][bs + 7]);
                pw[ks] = __builtin_bit_cast(bf16x8, w); }
            const LAS char* vp = sb + 16384 + ((lane >> 4) & 1) * 32 + (lane & 3) * 8 + (4 * hi + ((lane & 15) >> 2)) * 64;
            if (NMAP == 1) {
#pragma unroll
                for (int ks = 0; ks < 4; ++ks) ol = __builtin_amdgcn_mfma_f32_32x32x16_bf16(pw[ks], ones, ol, 0, 0, 0);
            }
#pragma unroll
            for (int d = 0; d < ND; ++d)
#pragma unroll
                for (int ks = 0; ks < 4; ++ks) { const s16x4 lo = vtr(vp + d * 4096 + ks * 1024), hh = vtr(vp + d * 4096 + ks * 1024 + 512);
                    const bf16x8 vf = (bf16x8){lo[0], lo[1], lo[2], lo[3], hh[0], hh[1], hh[2], hh[3]};
                    o[d] = __builtin_amdgcn_mfma_f32_32x32x16_bf16(pw[ks], vf, o[d], 0, 0, 0); }
        }
        if (NMAP == 1 && wid == 0 && t + 1 < NT) ((LAS float*)(lds + AT_CK + (st ^ 1) * 256))[lane] = ckn;
    }
    float inv[16];
    if (NMAP == 1) {
#pragma unroll
        for (int r = 0; r < 16; ++r) inv[r] = fast_rcp(ol[r]);
    } else {
        LAS float* wsf = (LAS float*)(lds + AT_WSF) + wid * 32;
        const float lt = red32_add(lsum);
        asm volatile("s_waitcnt lgkmcnt(0)" ::: "memory");
        if (hi == 0) wsf[r32] = fast_rcp(lt);
        asm volatile("s_waitcnt lgkmcnt(0)" ::: "memory");
#pragma unroll
        for (int r = 0; r < 16; ++r) inv[r] = wsf[crow(r, hi)];
        asm volatile("s_waitcnt lgkmcnt(0)" ::: "memory");
    }
    if (NMAP == 1) {
        bf16_t* Ow = P.O + (rowbase + qw0) * DM + 512 + h * 64 + r32;
#pragma unroll
        for (int r = 0; r < 16; ++r)
#pragma unroll
            for (int d = 0; d < ND; ++d) Ow[(size_t)crow(r, hi) * DM + d * 32] = (bf16_t)(cvt_pk_bf16(o[d][r] * inv[r], 0.f) & 0xffffu);
        __syncthreads();
    } else {
        __syncthreads();
        LAS float* xb = (LAS float*)lds + (size_t)rb * (ND * 16 * 64) + lane;
        if (mp == 1) {
#pragma unroll
            for (int d = 0; d < ND; ++d)
#pragma unroll
                for (int r = 0; r < 16; ++r) xb[(d * 16 + r) * 64] = o[d][r] * inv[r];
        }
        __syncthreads();
        if (mp == 0) {
            float ss[16];
#pragma unroll
            for (int r = 0; r < 16; ++r) {
                float s = 0.f;
#pragma unroll
                for (int d = 0; d < ND; ++d) { const float v = o[d][r] * inv[r] - P.lam * xb[(d * 16 + r) * 64]; o[d][r] = v; s += v * v; }
                s += swz_xor<1>(s); s += swz_xor<2>(s); s += swz_xor<4>(s); s += swz_xor<8>(s); s += swz_xor<16>(s);
                ss[r] = rsqrtf(s * (1.0f / 128.0f) + EPS) * (1.0f - P.lam_init);
            }
            bf16_t* Ow = P.O + (rowbase + qw0) * DM + h * 128 + r32;
#pragma unroll
            for (int d = 0; d < ND; ++d) { const float gd = P.subg[d * 32 + r32];
#pragma unroll
                for (int r = 0; r < 16; ++r) Ow[(size_t)crow(r, hi) * DM + d * 32] = (bf16_t)(cvt_pk_bf16(o[d][r] * ss[r] * gd, 0.f) & 0xffffu); }
        }
        __syncthreads();
    }
}

__device__ void attn_phase(ArgsP a, int j, LAS unsigned char* lds) {
    const int tid = opaque_tid(), lane = tid & 63;
    AttnP P;
    P.Q = (const bf16_t*)(a->ws + WS_R + R_Q); P.K = (const bf16_t*)(a->ws + WS_R + R_K); P.V = (const bf16_t*)(a->ws + WS_R + R_V); P.O = (bf16_t*)(a->ws + WS_R + R_Q);
    P.cum = (const float*)(a->ws + WS_CUM); P.relb = a->in[22]; P.subg = a->in[19] + j * 128;
    const float d1 = wave_sum(a->in[15][j * 64 + lane] * a->in[16][j * 64 + lane]), d2 = wave_sum(a->in[17][j * 64 + lane] * a->in[18][j * 64 + lane]);
    {
        float gdq = fabsf(a->in[13][j * 64 + lane]), gdk = fabsf(a->in[14][j * 64 + lane]), gfq = fabsf(a->in[20][j * 64 + lane]), gfk = fabsf(a->in[21][j * 64 + lane]);
#define WMAX(v) v = fmaxf(v, swz_xor<1>(v)); v = fmaxf(v, swz_xor<2>(v)); v = fmaxf(v, swz_xor<4>(v)); v = fmaxf(v, swz_xor<8>(v)); v = fmaxf(v, swz_xor<16>(v)); v = red32_max(v)
        WMAX(gdq); WMAX(gdk); WMAX(gfq); WMAX(gfk);
#undef WMAX
        P.ref_diff = __int_as_float(__builtin_amdgcn_readfirstlane(__float_as_int(64.0f * QSCALE * 1.02f * gdq * gdk)));
        P.ref_fox = __int_as_float(__builtin_amdgcn_readfirstlane(__float_as_int(64.0f * QSCALE * 1.02f * gfq * gfk)));
    }
    const int jo = opaque_s(j);
    const float li_ = (jo == 0) ? 0.2f : 0.47071301821013583f;
    P.lam_init = li_;
    P.lam = __int_as_float(__builtin_amdgcn_readfirstlane(__float_as_int(expf(d1) - expf(d2) + li_)));
    unsigned* ctr = (unsigned*)(a->ws + WS_CTL) + 64 * (1 + j);
    LAS unsigned* misc = (LAS unsigned*)(lds + AT_MISC);
    for (;;) {
        if (tid == 0) misc[0] = atomicAdd(ctr, 1u);
        __syncthreads();
        const int idx = (int)misc[0];
        __syncthreads();
        if (idx >= 2048) break;
        int type, bh, L;
        if (idx < 512) { L = 32 - (idx >> 5); type = 1; bh = idx & 31; }
        else { const int jj = idx - 512; L = 16 - jj / 96; const int r = jj % 96; if (r < 32) { type = 1; bh = r; } else { type = 0; bh = r - 32; } }
        if (type == 0) attn_unit<1>(lds, P, bh >> 3, bh & 7, L - 1);
        else attn_unit<2>(lds, P, bh >> 2, bh & 3, L - 1);
    }
}

#define XB_XCNT(j)  (256  + 64 * (j))
#define XB_XSUB(j)  (1280 + 64 * (j))
#define XB_XGEN(j)  (2304 + 64 * (j))
#define XB_TOP      3328
#define XB_TOPGEN   3392
constexpr int CW_BAR = 4096;
constexpr int LDS_BARST = 131072 + 12288 + 1024 + 256;
__device__ __forceinline__ unsigned xb_ld(unsigned* p)              { return __hip_atomic_load(p, __ATOMIC_RELAXED, __HIP_MEMORY_SCOPE_AGENT); }
__device__ __forceinline__ unsigned xb_add(unsigned* p, unsigned v) { return __hip_atomic_fetch_add(p, v, __ATOMIC_RELAXED, __HIP_MEMORY_SCOPE_AGENT); }
__device__ __forceinline__ unsigned xb_xcc_id() { return (unsigned)__builtin_amdgcn_s_getreg((3 << 11) | 20) & 0xFu; }
#define XB_SPIN(cond) do { unsigned _sp = 0; while (cond) { __builtin_amdgcn_s_sleep(1); if (++_sp > (1u << 24)) break; } } while (0)
__device__ __forceinline__ void grid_barrier(unsigned* ctl, unsigned G) {
    unsigned* bar = ctl + CW_BAR;
    const int tid = opaque_tid();
    asm volatile("s_waitcnt vmcnt(0) lgkmcnt(0)" ::: "memory");
    __syncthreads();
    if (tid == 0) {
        volatile LAS unsigned* st = (volatile LAS unsigned*)((LAS unsigned char*)lds_raw + LDS_BARST);
        const unsigned x = xb_xcc_id();
        unsigned nloc = st[0], nx = st[1];
        if (nloc == 0u) {
            unsigned sum, cnt, mine, sp = 0u;
            for (;;) {
                sum = 0u; cnt = 0u; mine = 0u;
#pragma unroll
                for (unsigned j = 0; j < 16; ++j) { const unsigned c = xb_ld(&bar[XB_XCNT(j)]); sum += c; cnt += (c > 0u) ? 1u : 0u; mine = (j == x) ? c : mine; }
                if (sum == G) break;
                __builtin_amdgcn_s_sleep(1);
                if (++sp > (1u << 22)) break;
            }
            nloc = mine > 0u ? mine : 1u; nx = cnt > 0u ? cnt : 1u; st[0] = nloc; st[1] = nx;
        }
        const unsigned old = xb_add(&bar[XB_XSUB(x)], 1u);
        const unsigned gen = old / nloc;
        if (old + 1u == (gen + 1u) * nloc) {
            __builtin_amdgcn_fence(__ATOMIC_RELEASE, "agent");
            asm volatile("s_waitcnt vmcnt(0)" ::: "memory");
            const unsigned og = xb_add(&bar[XB_TOP], 1u);
            const unsigned tg = og / nx;
            if (og + 1u == (tg + 1u) * nx) xb_add(&bar[XB_TOPGEN], 1u);
            else XB_SPIN(xb_ld(&bar[XB_TOPGEN]) == tg);
            __builtin_amdgcn_fence(__ATOMIC_ACQUIRE, "agent");
            xb_add(&bar[XB_XGEN(x)], 1u);
            asm volatile("s_waitcnt vmcnt(0)" ::: "memory");
        } else {
            XB_SPIN(xb_ld(&bar[XB_XGEN(x)]) == gen);
            __builtin_amdgcn_fence(__ATOMIC_ACQUIRE, "agent");
            asm volatile("s_waitcnt vmcnt(0)" ::: "memory");
        }
    }
    __syncthreads();
}

__global__ void __launch_bounds__(512, 2) fwd_megakernel(Args a_unused) {
    LAS unsigned char* lds = (LAS unsigned char*)lds_raw;
    cg::grid_group grid = cg::this_grid();
    const int G0 = gridDim.x, bx0 = blockIdx.x;
#define G opaque_s(G0)
#define bx opaque_s(bx0)
    LAS float* rs = (LAS float*)(lds + LDS_RS);
    { const int t0 = threadIdx.x; const int key = hw_wave_key(); if ((t0 & 63) == 0) *(volatile LAS int*)(lds + LDS_WIDTAB + key * 4) = t0 >> 6; }
    if (threadIdx.x == 0) { volatile LAS unsigned* st = (volatile LAS unsigned*)(lds + LDS_BARST); st[0] = 0u; st[1] = 0u;
        (void)xb_add((unsigned*)(kargs()->ws + WS_CTL) + CW_BAR + XB_XCNT(xb_xcc_id()), 1u); }
    grid.sync();
#define GRID_SYNC() grid_barrier((unsigned*)(kargs()->ws + WS_CTL), (unsigned)G)

    {
        ArgsP a = kargs();
        const int tid = opaque_tid(), lane = tid & 63, wid = tid >> 6, Gp = G, bxp = bx;
        LAS float* scr = (LAS float*)(lds + wid * 16384);
        const int gw = bxp * 8 + wid, NGW = Gp * 8;
        for (int it = gw; it < N_CONVERT_ITEMS; it += NGW) convert_item(a, it, scr, lane);
        bf16_t* XB = (bf16_t*)(a->ws + WS_XB); float* SS = (float*)(a->ws + WS_SS); const float* xin = a->in[0];
        for (int m = gw; m < MTOK; m += NGW) {
            const f32x4* xr = (const f32x4*)(xin + (size_t)m * DM) + lane;
            u32x2* ob = (u32x2*)(XB + (size_t)m * DM) + lane;
            float s = 0.f;
#pragma unroll
            for (int jx = 0; jx < 4; ++jx) { const f32x4 v = xr[64 * jx]; s += (v[0] * v[0] + v[1] * v[1]) + (v[2] * v[2] + v[3] * v[3]);
                u32x2 w; w.x = cvt_pk_bf16(v[0], v[1]); w.y = cvt_pk_bf16(v[2], v[3]); ob[64 * jx] = w; }
            s = wave_sum(s);
            if (lane < 32) SS[(size_t)m * 32 + lane] = lane == 0 ? s : 0.f;
        }
    }
    GRID_SYNC();

#pragma unroll 1
    for (int layer = 0; layer < 4; ++layer) {
        const int j = layer >> 1;
#pragma unroll 1
        for (int f = 0; f < 2; ++f) {
            if (f == 1) {
                if ((layer & 1) == 0) {
                    {
                        ArgsP a = kargs(); unsigned char* ws = a->ws;
                        {
                            const int t = opaque_tid();
                            if (t < 256) { const int sel = t >> 6, d = t & 63; const float* gp = a->in[sel == 0 ? 13 : (sel == 1 ? 14 : (sel == 2 ? 20 : 21))]; ((LAS float*)(lds + LDS_GT))[t] = gp[j * 64 + d]; }
                        }
                        pg8::Gemm g{(const bf16_t*)(ws + WS_XB), (const bf16_t*)(ws + WS_WIN + (size_t)j * WIN_SZ), DM, DM, DM};
                        pg8::StaticOrder S; S.init(MTOK, 3328, G, bx);
                        compute_rowscale(S, (const float*)(ws + WS_SS), rs);
                        pg8::EpiInProj E{(bf16_t*)(ws + WS_R + R_Q), (float*)(ws + WS_LF), rs, (const LAS float*)(lds + LDS_GT), a->in[12] + j * 8};
                        pg8::gemm_phase(lds, g, S, E);
                    }
                    GRID_SYNC();
                    {
                        ArgsP a = kargs();
                        const int bxp = bx;
                        if (bxp < 64) cumsum_bh(a, bxp, lds);
                        else s5_setup(a, j, (bxp - 64) / 3, (bxp - 64) % 3, lds);
                    }
                    GRID_SYNC();
                    attn_phase(kargs(), j, lds);
                    GRID_SYNC();
                    {
                        ArgsP a = kargs(); unsigned char* ws = a->ws;
                        pg8::Gemm g{(const bf16_t*)(ws + WS_R + R_Q), (const bf16_t*)(ws + WS_WOUT + (size_t)j * WOUT_SZ), DM, DM, DM};
                        pg8::StaticOrder S; S.init(MTOK, DM, G, bx);
                        pg8::EpiResAdd E{nullptr, (bf16_t*)(ws + WS_XB), (float*)(ws + WS_SS), 1.0f};
                        pg8::gemm_phase(lds, g, S, E);
                    }
                    GRID_SYNC();
                } else {
                    s5_build_u(kargs(), layer, lds);
                    GRID_SYNC();
                    {
                        ArgsP a = kargs(); unsigned char* ws = a->ws;
                        pg8::Gemm g{(const bf16_t*)(ws + WS_R + R_UA), (const bf16_t*)(ws + WS_S5W1), 640, 512, 512};
                        pg8::S5StateOrder S{G, bx};
                        pg8::EpiS5State E{(float*)(ws + WS_R + R_SST)};
                        pg8::gemm_phase(lds, g, S, E);
                    }
                    GRID_SYNC();
                    s5_scan(kargs(), j);
                    GRID_SYNC();
                    {
                        ArgsP a = kargs(); unsigned char* ws = a->ws;
                        pg8::Gemm g{(const bf16_t*)(ws + WS_R + R_UA), (const bf16_t*)(ws + WS_S5WA), 640, 640, 640};
                        pg8::S5OutOrder S{G, bx};
                        pg8::EpiS5Out E{(const bf16_t*)(ws + WS_R + R_UA), a->in[30] + j * DM, (bf16_t*)(ws + WS_R + R_Y)};
                        pg8::gemm_phase(lds, g, S, E);
                    }
                    GRID_SYNC();
                    {
                        ArgsP a = kargs(); unsigned char* ws = a->ws;
                        pg8::Gemm g{(const bf16_t*)(ws + WS_R + R_Y), (const bf16_t*)(ws + WS_WGLU + (size_t)j * WGLU_SZ), DM, DM, DM};
                        pg8::StaticOrder S; S.init(MTOK, 2048, G, bx);
                        pg8::EpiGlu E{(bf16_t*)(ws + WS_XB), (float*)(ws + WS_SS)};
                        pg8::gemm_phase(lds, g, S, E);
                    }
                    GRID_SYNC();
                }
            }
            const int mi = layer * 2 + f;
            {
                ArgsP a = kargs(); unsigned char* ws = a->ws;
                pg8::Gemm g{(const bf16_t*)(ws + WS_XB), (const bf16_t*)(ws + WS_WGU + (size_t)mi * WGU_SZ), DM, DM, DM};
                pg8::StaticOrder S; S.init(MTOK, 5632, G, bx);
                compute_rowscale(S, (const float*)(ws + WS_SS), rs);
                pg8::EpiGateUp E{(bf16_t*)(ws + WS_R + R_H), rs};
                pg8::gemm_phase(lds, g, S, E);
            }
            GRID_SYNC();
            {
                ArgsP a = kargs(); unsigned char* ws = a->ws;
                pg8::Gemm g{(const bf16_t*)(ws + WS_R + R_H), (const bf16_t*)(ws + WS_WDN + (size_t)mi * WDN_SZ), FF, FF, FF};
                pg8::StaticOrder S; S.init(MTOK, DM, G, bx);
                pg8::EpiResAdd E{(mi == 7) ? a->out : nullptr, (bf16_t*)(ws + WS_XB), (float*)(ws + WS_SS), 0.5f};
                pg8::gemm_phase(lds, g, S, E);
            }
            GRID_SYNC();
        }
    }
}
#undef G
#undef bx
#undef GRID_SYNC

extern "C" void kernel_launch(void* const* d_in, const int* in_sizes, int n_in, void* d_out, int out_size, void* d_ws, size_t ws_size, hipStream_t stream) {
    static int grid = 0;
    if (grid == 0) {
        if (n_in != 33 || out_size != MTOK * DM || ws_size < WS_END) { fprintf(stderr, "kernel_launch: unexpected shapes (n_in %d out %d ws %zu, need ws >= %zu)\n", n_in, out_size, ws_size, (size_t)WS_END); grid = -1; return; }
        int dev = 0, cus = 0, per_cu = 0;
        hipGetDevice(&dev); hipDeviceGetAttribute(&cus, hipDeviceAttributeMultiprocessorCount, dev);
        hipFuncSetAttribute((const void*)fwd_megakernel, hipFuncAttributeMaxDynamicSharedMemorySize, LDS_BYTES);
        hipOccupancyMaxActiveBlocksPerMultiprocessor(&per_cu, (const void*)fwd_megakernel, 512, LDS_BYTES);
        (void)hipGetLastError();
        if (per_cu < 1) { fprintf(stderr, "kernel_launch: occupancy query says %d blocks/CU\n", per_cu); per_cu = 1; }
        grid = cus;
        if (grid != 256) fprintf(stderr, "kernel_launch: warning: %d CUs (built for 256)\n", grid);
    }
    if (grid < 0) return;
    hipMemsetAsync((char*)d_ws + WS_CTL, 0, 65536, stream);
    Args a{};
    for (int i = 0; i < 33; ++i) a.in[i] = (const float*)d_in[i];
    a.out = (float*)d_out; a.ws = (unsigned char*)d_ws;
    void* args[] = {&a};
    hipError_t e = hipLaunchCooperativeKernel((const void*)fwd_megakernel, dim3(grid), dim3(512), args, LDS_BYTES, stream);
    if (e != hipSuccess) fprintf(stderr, "cooperative launch failed: %s (grid %d)\n", hipGetErrorString(e), grid);
}
```

```cpp
#include <hip/hip_runtime.h>
#include <hip/hip_cooperative_groups.h>
#include <cstdio>
#include <cstdint>
#include <cmath>
namespace cg = cooperative_groups;

#define LAS __attribute__((address_space(3)))
typedef unsigned short bf16_t;
typedef short bf16x8 __attribute__((ext_vector_type(8)));
typedef short s16x4 __attribute__((ext_vector_type(4)));
typedef float f32x4 __attribute__((ext_vector_type(4)));
typedef float f32x16 __attribute__((ext_vector_type(16)));
typedef unsigned u32x4 __attribute__((ext_vector_type(4)));
typedef unsigned u32x2 __attribute__((ext_vector_type(2)));

constexpr int MTOK = 32768, DM = 1024, FF = 2816, SEQ = 4096, NB = 8;
constexpr float EPS = 1e-6f;
constexpr float LOG2E = 1.4426950408889634f;
constexpr float QSCALE = 0.125f * LOG2E;

constexpr size_t MiB = 1u << 20;
constexpr size_t WS_CTL = 0;
constexpr size_t WS_SS = 1 * MiB;
constexpr size_t WS_LF = 5 * MiB;
constexpr size_t WS_CUM = 6 * MiB;
constexpr size_t WS_WGU = 8 * MiB;
constexpr size_t WGU_SZ = (size_t)5632 * 1024 * 2;
constexpr size_t WS_WDN = 96 * MiB;
constexpr size_t WDN_SZ = (size_t)1024 * 2816 * 2;
constexpr size_t WS_WIN = 140 * MiB;
constexpr size_t WIN_SZ = (size_t)3328 * 1024 * 2;
constexpr size_t WS_WOUT = 153 * MiB;
constexpr size_t WOUT_SZ = (size_t)1024 * 1024 * 2;
constexpr size_t WS_WGLU = 157 * MiB;
constexpr size_t WGLU_SZ = (size_t)2048 * 1024 * 2;
constexpr size_t WS_S5W1 = 165 * MiB;
constexpr size_t WS_S5WA = 181 * MiB;
constexpr size_t WS_XB = 221 * MiB;
constexpr size_t WS_R = 285 * MiB;
constexpr size_t WS_END = 477 * MiB;
constexpr size_t R_H = 0;
constexpr size_t R_Q = 0, R_K = 64 * MiB, R_V = 128 * MiB;
constexpr size_t R_UA = 0;
constexpr size_t R_SST = 80 * MiB;
constexpr size_t R_Y = 112 * MiB;

constexpr int LDS_BYTES = 147456;
constexpr int LDS_RS = 131072;
constexpr int LDS_GT = 131072 + 12288;

typedef float f32x2_t __attribute__((ext_vector_type(2))); typedef __bf16 bf16x2_t __attribute__((ext_vector_type(2)));
__device__ __forceinline__ unsigned cvt_pk_bf16(float lo, float hi) { const f32x2_t v = {lo, hi}; const bf16x2_t b = __builtin_convertvector(v, bf16x2_t); return __builtin_bit_cast(unsigned, b); }
__device__ __forceinline__ float bf_lo(unsigned w) { return __uint_as_float(w << 16); }
__device__ __forceinline__ float bf_hi(unsigned w) { return __uint_as_float(w & 0xffff0000u); }
__device__ __forceinline__ float fast_exp2(float x) { return __builtin_amdgcn_exp2f(x); }
__device__ __forceinline__ float fast_rcp(float x) { return __builtin_amdgcn_rcpf(x); }
__device__ __forceinline__ float sigmoidf_(float x) { return fast_rcp(1.0f + fast_exp2(-x * LOG2E)); }
__device__ __forceinline__ float gelu_tanh(float y) { const float z = 1.5957691216057308f * (y + 0.044715f * y * y * y); return y * sigmoidf_(z); }
__device__ __forceinline__ u32x4 pack8(f32x4 a, f32x4 b) { u32x4 w; w.x = cvt_pk_bf16(a[0], a[1]); w.y = cvt_pk_bf16(a[2], a[3]); w.z = cvt_pk_bf16(b[0], b[1]); w.w = cvt_pk_bf16(b[2], b[3]); return w; }

template <int K> __device__ __forceinline__ float swz_xor(float v) { return __int_as_float(__builtin_amdgcn_ds_swizzle(__float_as_int(v), 0x1f | (K << 10))); }
__device__ __forceinline__ float red32_add(float v) { auto rr = __builtin_amdgcn_permlane32_swap(__float_as_uint(v), __float_as_uint(v), false, false); return __uint_as_float(rr[0]) + __uint_as_float(rr[1]); }
__device__ __forceinline__ float red32_max(float v) { auto rr = __builtin_amdgcn_permlane32_swap(__float_as_uint(v), __float_as_uint(v), false, false); return fmaxf(__uint_as_float(rr[0]), __uint_as_float(rr[1])); }
__device__ __forceinline__ float red16_add(float v) { return v + swz_xor<16>(v); }
extern __shared__ __attribute__((aligned(16))) unsigned char lds_raw[];
constexpr int LDS_WIDTAB = 131072 + 12288 + 1024;
__device__ __forceinline__ int opaque_s(int v) { asm volatile("" : "+s"(v)); return v; }
__device__ __forceinline__ int hw_wave_key() { int k; asm volatile("s_getreg_b32 %0, hwreg(HW_REG_HW_ID, 0, 6)" : "=s"(k)); return k & 63; }
__device__ __forceinline__ int opaque_tid() {
    int lane; asm volatile("v_mbcnt_lo_u32_b32 %0, -1, 0\n\tv_mbcnt_hi_u32_b32 %0, -1, %0" : "=v"(lane));
    const int key = hw_wave_key();
    const int wid = __builtin_amdgcn_readfirstlane(*(volatile LAS int*)((LAS unsigned char*)lds_raw + LDS_WIDTAB + key * 4));
    return wid * 64 + lane;
}
namespace pg8 {
constexpr int BM = 256, BK = 64, HALF = 128, HTB = HALF * BK * 2, STAGE_BYTES = 8 * HTB, NXCD = 8, WGM = 8;
__host__ __device__ __forceinline__ int lds_byte(int r, int c) { const int st = (r >> 4) * 2 + (c >> 5), rr = r & 15, cc = c & 31, ob = rr * 64 + cc * 2; return st * 1024 + (ob ^ (((ob >> 9) & 1) << 5)); }
__host__ __device__ __forceinline__ void stage_rc(int b, int& R, int& C) { const int st = b / 1024, sb = b % 1024, swz = sb ^ (((sb >> 9) & 1) << 5); R = (st >> 1) * 16 + swz / 64; C = (st & 1) * 32 + (swz % 64) / 2; }
__host__ __device__ __forceinline__ int perm32(int rho) { const int n = rho >> 4, i = rho & 15; return 8 * (i >> 2) + 4 * n + (i & 3); }

struct Unit { int pm, pn; };
struct Gemm { const bf16_t* A; const bf16_t* Bt; int lda, ldb, K; };

struct StaticOrder {
    int nM, nN, nwg, G, c;
    __device__ void init(int M, int N, int G_, int c_) { nM = M / BM; nN = N / BM; nwg = nM * nN; G = G_; c = c_; }
    __device__ bool next(int i, Unit& u) const {
        const long L = (long)i * G + c; if (L >= nwg) return false;
        int wgid = (int)L; { const int q = nwg / NXCD, r = nwg % NXCD, xcd = wgid % NXCD, off = wgid / NXCD; wgid = (xcd < r ? xcd * (q + 1) : r * (q + 1) + (xcd - r) * q) + off; }
        const int nig = WGM * nN, gid = wgid / nig, fm = gid * WGM, gsz = (nM - fm) < WGM ? (nM - fm) : WGM;
        u.pm = fm + ((wgid % nig) % gsz); u.pn = (wgid % nig) / gsz; return true;
    }
};
struct S5StateOrder {
    int G, c;
    __device__ bool next(int i, Unit& u) const { const int L = i * G + c; if (L >= 256) return false; u.pm = L; u.pn = L >> 2; return true; }
};
struct S5OutOrder {
    int G, c;
    __device__ bool next(int i, Unit& u) const { const int L = i * G + c; if (L >= 512) return false; const int g = L >> 3, r = L & 7; u.pm = 4 * g + (r >> 1); u.pn = 2 * g + (r & 1); return true; }
};

template <class Epi, class Sched>
__device__ __forceinline__ void gemm_phase(LAS unsigned char* lds, const Gemm g, const Sched& S, const Epi& E) {
    const int tid = opaque_tid(), wid = __builtin_amdgcn_readfirstlane(tid >> 6), lane = tid & 63, wr = wid >> 2, wc = wid & 3, fr = lane & 15, fq = lane >> 4;
    const int K = g.K, nt = K / BK;
    unsigned voffA[2], voffB[2];
#pragma unroll
    for (int i = 0; i < 2; ++i) { int R, C; stage_rc(tid * 16 + i * 8192, R, C); const int Rb = Epi::PERM ? ((R & ~31) + perm32(R & 31)) : R;
        voffA[i] = (unsigned)(R * g.lda + C) * 2u; voffB[i] = (unsigned)(Rb * g.ldb + C) * 2u; }
    const size_t kstep = (size_t)(BK * 2);
    const size_t hA = (size_t)HALF * g.lda * 2, hB = (size_t)HALF * g.ldb * 2;
    const size_t tA = 2 * hA, tB = 2 * hB;
    const unsigned ldsw = (unsigned)wid * 1024u;
    const int aoff = lds_byte(wr * 64 + fr, fq * 8), boff = lds_byte(wc * 32 + fr, fq * 8);
#define PG8_SA(b, h) (((b) * 2 + (h)) * HTB)
#define PG8_SB(b, h) ((4 + (b) * 2 + (h)) * HTB)
#define PG8_STAGE(bufoff, gbase, voff) do { _Pragma("unroll") for (int _i = 0; _i < 2; ++_i) \
        __builtin_amdgcn_global_load_lds((const unsigned*)((const char*)(gbase) + (voff)[_i]), (LAS unsigned*)(lds + (bufoff) + ldsw + _i * 8192), 16, 0, 0); } while (0)
#define PG8_LDA(dst, b, h) do { _Pragma("unroll") for (int m = 0; m < 4; ++m) _Pragma("unroll") for (int k = 0; k < 2; ++k) dst[m][k] = *(const LAS bf16x8*)(lds + PG8_SA(b, h) + aoff + m * 2048 + k * 1024); } while (0)
#define PG8_LDB(dst, b, h) do { _Pragma("unroll") for (int n = 0; n < 2; ++n) _Pragma("unroll") for (int k = 0; k < 2; ++k) dst[n][k] = *(const LAS bf16x8*)(lds + PG8_SB(b, h) + boff + n * 2048 + k * 1024); } while (0)
#define PG8_MMA(ai, bj, At, Bt) do { __builtin_amdgcn_s_setprio(1); _Pragma("unroll") for (int m = 0; m < 4; ++m) _Pragma("unroll") for (int n = 0; n < 2; ++n) _Pragma("unroll") for (int k = 0; k < 2; ++k) \
        acc[ai][bj][m][n] = __builtin_amdgcn_mfma_f32_16x16x32_bf16(Bt[n][k], At[m][k], acc[ai][bj][m][n], 0, 0, 0); __builtin_amdgcn_s_setprio(0); } while (0)
#define PG8_WAIT_V(n) asm volatile("s_waitcnt vmcnt(" #n ")" ::: "memory")
#define PG8_WAIT_L(n) asm volatile("s_waitcnt lgkmcnt(" #n ")" ::: "memory")
#define PG8_BAR __builtin_amdgcn_s_barrier()
#define PG8_SCHED __builtin_amdgcn_sched_barrier(0)
    Unit cur, nxt; int ui = 0;
    if (!S.next(0, cur)) return;
    f32x4 acc[2][2][4][2];
#pragma unroll
    for (int a = 0; a < 2; ++a)
#pragma unroll
        for (int b = 0; b < 2; ++b)
#pragma unroll
            for (int m = 0; m < 4; ++m)
#pragma unroll
                for (int n = 0; n < 2; ++n) acc[a][b][m][n] = (f32x4){0.f, 0.f, 0.f, 0.f};
    bf16x8 At[4][2], B0[2][2], B1[2][2];
    const char* cA = (const char*)g.A + (size_t)cur.pm * tA; const char* cB = (const char*)g.Bt + (size_t)cur.pn * tB;
    PG8_STAGE(PG8_SB(0, 0), cB, voffB); PG8_STAGE(PG8_SB(0, 1), cB + hB, voffB); PG8_STAGE(PG8_SA(0, 0), cA, voffA); PG8_STAGE(PG8_SA(0, 1), cA + hA, voffA);
    if (wr == 1) PG8_BAR;
    PG8_WAIT_V(2); PG8_BAR;
    PG8_STAGE(PG8_SB(1, 0), cB + kstep, voffB); PG8_STAGE(PG8_SA(1, 0), cA + kstep, voffA); PG8_STAGE(PG8_SB(1, 1), cB + hB + kstep, voffB);
    PG8_WAIT_V(6); PG8_BAR;
    for (;;) {
        const bool has_next = S.next(ui + 1, nxt);
        const char* nA = has_next ? (const char*)g.A + (size_t)nxt.pm * tA : cA; const char* nB = has_next ? (const char*)g.Bt + (size_t)nxt.pn * tB : cB;
        for (int t = 0; t < nt; t += 2) {
            const bool last = (t == nt - 2);
            const char* a1 = cA + (size_t)(t + 1) * kstep;
            const char* a2 = last ? nA : cA + (size_t)(t + 2) * kstep; const char* b2 = last ? nB : cB + (size_t)(t + 2) * kstep;
            const char* a3 = a2 + kstep; const char* b3 = b2 + kstep;
            PG8_LDB(B0, 0, 0); PG8_LDB(B1, 0, 1); PG8_SCHED; PG8_LDA(At, 0, 0); PG8_STAGE(PG8_SA(1, 1), a1 + hA, voffA);
            PG8_WAIT_V(8); PG8_WAIT_L(0); PG8_BAR; PG8_MMA(0, 0, At, B0); PG8_MMA(0, 1, At, B1); PG8_BAR; PG8_SCHED;
            PG8_LDA(At, 0, 1); PG8_STAGE(PG8_SB(0, 0), b2, voffB); PG8_STAGE(PG8_SB(0, 1), b2 + hB, voffB); PG8_STAGE(PG8_SA(0, 0), a2, voffA);
            PG8_WAIT_V(8); PG8_WAIT_L(0); PG8_BAR; PG8_MMA(1, 0, At, B0); PG8_MMA(1, 1, At, B1); PG8_BAR; PG8_SCHED;
            PG8_LDB(B0, 1, 0); PG8_LDB(B1, 1, 1); PG8_SCHED; PG8_LDA(At, 1, 0); PG8_STAGE(PG8_SA(0, 1), a2 + hA, voffA);
            PG8_WAIT_V(8); PG8_WAIT_L(0); PG8_BAR; PG8_MMA(0, 0, At, B0); PG8_MMA(0, 1, At, B1); PG8_BAR; PG8_SCHED;
            PG8_LDA(At, 1, 1); PG8_STAGE(PG8_SB(1, 0), b3, voffB); PG8_STAGE(PG8_SB(1, 1), b3 + hB, voffB); PG8_STAGE(PG8_SA(1, 0), a3, voffA);
            PG8_WAIT_V(8); PG8_WAIT_L(0); PG8_BAR; PG8_MMA(1, 0, At, B0); PG8_MMA(1, 1, At, B1); PG8_BAR; PG8_SCHED;
        }
        if (wr == 0) PG8_BAR;
        E(acc, cur, ui, wr, wc, fr, fq);
        if (!has_next) break;
#pragma unroll
        for (int a = 0; a < 2; ++a)
#pragma unroll
            for (int b = 0; b < 2; ++b)
#pragma unroll
                for (int m = 0; m < 4; ++m)
#pragma unroll
                    for (int n = 0; n < 2; ++n) acc[a][b][m][n] = (f32x4){0.f, 0.f, 0.f, 0.f};
        cur = nxt; cA = nA; cB = nB; ++ui;
        if (wr == 1) PG8_BAR;
    }
    PG8_WAIT_V(0);
    PG8_BAR;
#undef PG8_SA
#undef PG8_SB
#undef PG8_STAGE
#undef PG8_LDA
#undef PG8_LDB
#undef PG8_MMA
#undef PG8_WAIT_V
#undef PG8_WAIT_L
#undef PG8_BAR
#undef PG8_SCHED
}

typedef f32x4 AccT[2][2][4][2];

struct EpiGateUp {
    static constexpr bool PERM = true;
    bf16_t* H; const LAS float* rs;
    __device__ __forceinline__ void operator()(const AccT& acc, const Unit& u, int ui, int wr, int wc, int fr, int fq) const {
        const int col0 = u.pn * 128 + wc * 32 + 8 * fq;
#pragma unroll
        for (int ai = 0; ai < 2; ++ai)
#pragma unroll
            for (int m = 0; m < 4; ++m) {
                const int rt = ai * 128 + wr * 64 + m * 16 + fr; const float r = rs[ui * 256 + rt];
                f32x4 hv[2];
#pragma unroll
                for (int n = 0; n < 2; ++n) { const f32x4 gv = acc[ai][0][m][n] * r, uv = acc[ai][1][m][n] * r;
#pragma unroll
                    for (int i = 0; i < 4; ++i) hv[n][i] = gv[i] * sigmoidf_(gv[i]) * uv[i]; }
                *(u32x4*)(H + (size_t)(u.pm * 256 + rt) * FF + col0) = pack8(hv[0], hv[1]);
            }
    }
};
struct EpiResAdd {
    static constexpr bool PERM = true;
    float* OUT; bf16_t* XB; float* SS; float scale;
    __device__ __forceinline__ void operator()(const AccT& acc, const Unit& u, int ui, int wr, int wc, int fr, int fq) const {
        const int col0 = u.pn * 256 + wc * 32 + 8 * fq;
#pragma unroll
        for (int ai = 0; ai < 2; ++ai) {
            u32x4 w[4][2];
#pragma unroll
            for (int m = 0; m < 4; ++m)
#pragma unroll
                for (int bj = 0; bj < 2; ++bj) w[m][bj] = *(const u32x4*)(XB + ((size_t)u.pm * 256 + ai * 128 + wr * 64 + m * 16 + fr) * DM + col0 + bj * 128);
#pragma unroll
            for (int m = 0; m < 4; ++m) {
                const size_t row = (size_t)u.pm * 256 + ai * 128 + wr * 64 + m * 16 + fr;
#pragma unroll
                for (int bj = 0; bj < 2; ++bj) {
                    const u32x4 ww = w[m][bj];
                    f32x4 a = (f32x4){bf_lo(ww.x), bf_hi(ww.x), bf_lo(ww.y), bf_hi(ww.y)}, b = (f32x4){bf_lo(ww.z), bf_hi(ww.z), bf_lo(ww.w), bf_hi(ww.w)};
                    a = a + acc[ai][bj][m][0] * scale; b = b + acc[ai][bj][m][1] * scale;
                    if (OUT) { float* op = OUT + row * DM + col0 + bj * 128; *(f32x4*)op = a; *(f32x4*)(op + 4) = b; }
                    else {
                        *(u32x4*)(XB + row * DM + col0 + bj * 128) = pack8(a, b);
                        float ss = (a[0] * a[0] + a[1] * a[1]) + (a[2] * a[2] + a[3] * a[3]) + (b[0] * b[0] + b[1] * b[1]) + (b[2] * b[2] + b[3] * b[3]);
                        ss = red16_add(ss); ss = red32_add(ss);
                        if (fq == 0) SS[row * 32 + u.pn * 8 + bj * 4 + wc] = ss;
                    }
                }
            }
        }
    }
};
struct EpiGlu {
    static constexpr bool PERM = true;
    bf16_t* XB; float* SS;
    __device__ __forceinline__ void operator()(const AccT& acc, const Unit& u, int ui, int wr, int wc, int fr, int fq) const {
        const int col0 = u.pn * 128 + wc * 32 + 8 * fq;
        u32x4 w[2][4];
#pragma unroll
        for (int ai = 0; ai < 2; ++ai)
#pragma unroll
            for (int m = 0; m < 4; ++m) w[ai][m] = *(const u32x4*)(XB + ((size_t)u.pm * 256 + ai * 128 + wr * 64 + m * 16 + fr) * DM + col0);
#pragma unroll
        for (int ai = 0; ai < 2; ++ai)
#pragma unroll
            for (int m = 0; m < 4; ++m) {
                const size_t row = (size_t)u.pm * 256 + ai * 128 + wr * 64 + m * 16 + fr;
                const u32x4 ww = w[ai][m];
                f32x4 a = (f32x4){bf_lo(ww.x), bf_hi(ww.x), bf_lo(ww.y), bf_hi(ww.y)}, b = (f32x4){bf_lo(ww.z), bf_hi(ww.z), bf_lo(ww.w), bf_hi(ww.w)};
#pragma unroll
                for (int i = 0; i < 4; ++i) { a[i] += acc[ai][0][m][0][i] * sigmoidf_(acc[ai][1][m][0][i]); b[i] += acc[ai][0][m][1][i] * sigmoidf_(acc[ai][1][m][1][i]); }
                *(u32x4*)(XB + row * DM + col0) = pack8(a, b);
                float ss = (a[0] * a[0] + a[1] * a[1]) + (a[2] * a[2] + a[3] * a[3]) + (b[0] * b[0] + b[1] * b[1]) + (b[2] * b[2] + b[3] * b[3]);
                ss = red16_add(ss); ss = red32_add(ss);
                if (fq == 0) SS[row * 32 + u.pn * 4 + wc] = ss;
            }
    }
};
struct EpiInProj {
    static constexpr bool PERM = true;
    bf16_t* QKV; float* LF; const LAS float* rs; const LAS float* gt; const float* fgb;
    __device__ __forceinline__ void operator()(const AccT& acc, const Unit& u, int ui, int wr, int wc, int fr, int fq) const {
        if (u.pn == 12) {
            if (wc == 0 && fq == 0) {
                const f32x4 b0 = *(const f32x4*)fgb, b1 = *(const f32x4*)(fgb + 4);
#pragma unroll
                for (int ai = 0; ai < 2; ++ai)
#pragma unroll
                    for (int m = 0; m < 4; ++m) {
                        const int rt = ai * 128 + wr * 64 + m * 16 + fr; const float r = rs[ui * 256 + rt];
                        f32x4 z0 = acc[ai][0][m][0] * r + b0, z1 = acc[ai][0][m][1] * r + b1;
#pragma unroll
                        for (int i = 0; i < 4; ++i) { z0[i] = fminf(z0[i], 0.f) - log1pf(__expf(-fabsf(z0[i]))); z1[i] = fminf(z1[i], 0.f) - log1pf(__expf(-fabsf(z1[i]))); }
                        float* lp = LF + (size_t)(u.pm * 256 + rt) * 8; *(f32x4*)lp = z0; *(f32x4*)(lp + 4) = z1;
                    }
            }
            return;
        }
        const int sl = 4 * u.pn + wc, region = sl >> 3, within = sl & 7, kind = region % 3;
        const int colbase = (region >= 3 ? 512 : 0) + within * 64 + 8 * fq;
        bf16_t* dst = QKV + (size_t)kind * ((size_t)MTOK * DM);
        const int gsel = (region >= 3 ? 2 : 0) + (kind == 1 ? 1 : 0);
        f32x4 gn[2][2];
#pragma unroll
        for (int bj = 0; bj < 2; ++bj)
#pragma unroll
            for (int n = 0; n < 2; ++n) gn[bj][n] = *(const LAS f32x4*)(gt + gsel * 64 + 32 * bj + 8 * fq + 4 * n);
        const bool isv = (kind == 2);
        const float qs = kind == 0 ? QSCALE : 1.0f;
#pragma unroll
        for (int ai = 0; ai < 2; ++ai)
#pragma unroll
            for (int m = 0; m < 4; ++m) {
                const int rt = ai * 128 + wr * 64 + m * 16 + fr; const float r = rs[ui * 256 + rt];
                f32x4 v[2][2]; float ss = 0.f;
#pragma unroll
                for (int bj = 0; bj < 2; ++bj)
#pragma unroll
                    for (int n = 0; n < 2; ++n) { v[bj][n] = acc[ai][bj][m][n] * r; const f32x4 x = v[bj][n]; ss += (x[0] * x[0] + x[1] * x[1]) + (x[2] * x[2] + x[3] * x[3]); }
                ss = red16_add(ss); ss = red32_add(ss);
                const float rn = isv ? 1.0f : rsqrtf(ss * (1.0f / 64.0f) + EPS) * qs;
                bf16_t* rowp = dst + (size_t)(u.pm * 256 + rt) * DM + colbase;
#pragma unroll
                for (int bj = 0; bj < 2; ++bj) { f32x4 x0 = v[bj][0] * rn, x1 = v[bj][1] * rn; if (!isv) { x0 = x0 * gn[bj][0]; x1 = x1 * gn[bj][1]; } *(u32x4*)(rowp + 32 * bj) = pack8(x0, x1); }
            }
    }
};
struct EpiS5State {
    static constexpr bool PERM = true;
    float* SST;
    __device__ __forceinline__ void operator()(const AccT& acc, const Unit& u, int ui, int wr, int wc, int fr, int fq) const {
#pragma unroll
        for (int ai = 0; ai < 2; ++ai)
#pragma unroll
            for (int m = 0; m < 4; ++m) {
                const size_t row = (size_t)u.pm * 256 + ai * 128 + wr * 64 + m * 16 + fr;
                float* p = SST + row * 128 + wc * 32 + 8 * fq;
                *(f32x4*)p = acc[ai][0][m][0]; *(f32x4*)(p + 4) = acc[ai][0][m][1];
            }
    }
};
struct EpiS5Out {
    static constexpr bool PERM = true;
    const bf16_t* UA; const float* dsk; bf16_t* Y;
    __device__ __forceinline__ void operator()(const AccT& acc, const Unit& u, int ui, int wr, int wc, int fr, int fq) const {
        const int g = u.pm >> 2;
        f32x4 dv[2][2];
#pragma unroll
        for (int bj = 0; bj < 2; ++bj) { const int c0 = ((u.pn & 1) * 256 + bj * 128 + wc * 32 + 8 * fq) & 15; dv[bj][0] = *(const f32x4*)(dsk + g * 16 + c0); dv[bj][1] = *(const f32x4*)(dsk + g * 16 + c0 + 4); }
#pragma unroll
        for (int ai = 0; ai < 2; ++ai) {
            u32x4 uw[4][2];
#pragma unroll
            for (int m = 0; m < 4; ++m)
#pragma unroll
                for (int bj = 0; bj < 2; ++bj) uw[m][bj] = *(const u32x4*)(UA + (size_t)(u.pm * 256 + ai * 128 + wr * 64 + m * 16 + fr) * 640 + (u.pn & 1) * 256 + bj * 128 + wc * 32 + 8 * fq);
#pragma unroll
            for (int m = 0; m < 4; ++m) {
                const int row = u.pm * 256 + ai * 128 + wr * 64 + m * 16 + fr;
                const int n_ = row & 1023, b = n_ >> 7, k = n_ & 127;
#pragma unroll
                for (int bj = 0; bj < 2; ++bj) {
                    const int col8 = (u.pn & 1) * 256 + bj * 128 + wc * 32 + 8 * fq, t = col8 >> 4, c0 = col8 & 15;
                    const u32x4 w = uw[m][bj]; const f32x4 d0 = dv[bj][0], d1 = dv[bj][1];
                    f32x4 y0, y1;
                    y0[0] = acc[ai][bj][m][0][0] + d0[0] * bf_lo(w.x); y0[1] = acc[ai][bj][m][0][1] + d0[1] * bf_hi(w.x);
                    y0[2] = acc[ai][bj][m][0][2] + d0[2] * bf_lo(w.y); y0[3] = acc[ai][bj][m][0][3] + d0[3] * bf_hi(w.y);
                    y1[0] = acc[ai][bj][m][1][0] + d1[0] * bf_lo(w.z); y1[1] = acc[ai][bj][m][1][1] + d1[1] * bf_hi(w.z);
                    y1[2] = acc[ai][bj][m][1][2] + d1[2] * bf_lo(w.w); y1[3] = acc[ai][bj][m][1][3] + d1[3] * bf_hi(w.w);
#pragma unroll
                    for (int i = 0; i < 4; ++i) { y0[i] = gelu_tanh(y0[i]); y1[i] = gelu_tanh(y1[i]); }
                    *(u32x4*)(Y + ((size_t)b * SEQ + k * 32 + t) * DM + g * 16 + c0) = pack8(y0, y1);
                }
            }
        }
    }
};
}

struct Args { const float* in[33]; float* out; unsigned char* ws; };
typedef const __attribute__((address_space(4))) Args* ArgsP;
__device__ __forceinline__ ArgsP kargs() { ArgsP p = (ArgsP)__builtin_amdgcn_kernarg_segment_ptr(); asm volatile("" : "+s"(p)); return p; }

__device__ __forceinline__ float wave_sum(float v) {
    v += swz_xor<1>(v); v += swz_xor<2>(v); v += swz_xor<4>(v); v += swz_xor<8>(v); v += swz_xor<16>(v);
    return red32_add(v);
}

template <class Sched>
__device__ __forceinline__ void compute_rowscale(const Sched& S, const float* SS, LAS float* rs) {
    const int t = opaque_tid(), row = t >> 1, half = t & 1;
    pg8::Unit u;
    for (int ui = 0; S.next(ui, u); ++ui) {
        const float* p = SS + ((size_t)u.pm * 256 + row) * 32 + half * 16;
        const f32x4 a = *(const f32x4*)p, b = *(const f32x4*)(p + 4), c = *(const f32x4*)(p + 8), d = *(const f32x4*)(p + 12);
        float s = ((a[0] + a[1]) + (a[2] + a[3])) + ((b[0] + b[1]) + (b[2] + b[3])) + ((c[0] + c[1]) + (c[2] + c[3])) + ((d[0] + d[1]) + (d[2] + d[3]));
        s += swz_xor<1>(s);
        if (half == 0) rs[ui * 256 + row] = rsqrtf(s * (1.0f / 1024.0f) + EPS);
    }
    __syncthreads();
}

__device__ __forceinline__ void transpose_item(const float* W, int K, int srcN, int c0, int nvalid, const float* gain, bf16_t* WT, int n0, int k0, LAS float* scr, int lane) {
    const int cc = (lane & 7) * 4, r0 = lane >> 3;
    f32x4 v[8];
#pragma unroll
    for (int i = 0; i < 8; ++i) { const int kk = r0 + 8 * i; v[i] = (cc < nvalid) ? *(const f32x4*)(W + (size_t)(k0 + kk) * srcN + c0 + cc) : (f32x4){0.f, 0.f, 0.f, 0.f}; }
#pragma unroll
    for (int i = 0; i < 8; ++i) { const int kk = r0 + 8 * i; const float g = gain ? gain[k0 + kk] : 1.0f;
        LAS float* d = scr + kk * 33 + cc; d[0] = v[i][0] * g; d[1] = v[i][1] * g; d[2] = v[i][2] * g; d[3] = v[i][3] * g; }
    asm volatile("s_waitcnt lgkmcnt(0)" ::: "memory");
    const int c = lane & 7;
#pragma unroll
    for (int j = 0; j < 4; ++j) { const int n = (lane >> 3) + 8 * j; const LAS float* s = scr + (8 * c) * 33 + n;
        u32x4 o; o.x = cvt_pk_bf16(s[0 * 33], s[1 * 33]); o.y = cvt_pk_bf16(s[2 * 33], s[3 * 33]); o.z = cvt_pk_bf16(s[4 * 33], s[5 * 33]); o.w = cvt_pk_bf16(s[6 * 33], s[7 * 33]);
        *(u32x4*)(WT + (size_t)(n0 + n) * K + k0 + 8 * c) = o; }
    asm volatile("s_waitcnt lgkmcnt(0)" ::: "memory");
}

__device__ __forceinline__ void convert_item(ArgsP a, int it, LAS float* scr, int lane) {
    unsigned char* ws = a->ws;
    if (it < 8 * 2816) {
        const int mi = it / 2816, r = it % 2816, l = mi >> 1, f = mi & 1;
        const int nblk = 5632 / 32, kb = r / nblk, nb = r % nblk, n0 = 32 * nb, pn = n0 >> 8, tc = n0 & 255, bj = tc >> 7, j = tc & 127;
        const float* W = (bj ? a->in[f ? 8 : 3] : a->in[f ? 7 : 2]) + (size_t)l * DM * FF;
        const float* gain = a->in[f ? 6 : 1] + l * DM;
        transpose_item(W, DM, FF, 128 * pn + j, 32, gain, (bf16_t*)(ws + WS_WGU + (size_t)mi * WGU_SZ), n0, 64 * kb, scr, lane);
        return;
    }
    it -= 8 * 2816;
    if (it < 8 * 1408) {
        const int mi = it / 1408, r = it % 1408, l = mi >> 1, f = mi & 1;
        const int nblk = 32, kb = r / nblk, nb = r % nblk;
        const float* W = a->in[f ? 9 : 4] + (size_t)l * FF * DM;
        transpose_item(W, FF, DM, 32 * nb, 32, nullptr, (bf16_t*)(ws + WS_WDN + (size_t)mi * WDN_SZ), 32 * nb, 64 * kb, scr, lane);
        return;
    }
    it -= 8 * 1408;
    const int j = it / 3200; int r = it % 3200;
    if (r < 1664) {
        const int nblk = 104, kb = r / nblk, nb = r % nblk, n0 = 32 * nb, pn = n0 >> 8, tc = n0 & 255;
        int c0, nvalid;
        if (pn < 12) { const int bj = tc >> 7, wc = (tc & 127) >> 5; c0 = (4 * pn + wc) * 64 + 32 * bj; nvalid = 32; }
        else { c0 = 3072; nvalid = (tc == 0) ? 8 : 0; }
        transpose_item(a->in[10] + (size_t)j * DM * 3080, DM, 3080, c0, nvalid, a->in[5] + (2 * j) * DM, (bf16_t*)(ws + WS_WIN + (size_t)j * WIN_SZ), n0, 64 * kb, scr, lane);
        return;
    }
    r -= 1664;
    if (r < 512) {
        const int nblk = 32, kb = r / nblk, nb = r % nblk;
        transpose_item(a->in[11] + (size_t)j * DM * DM, DM, DM, 32 * nb, 32, nullptr, (bf16_t*)(ws + WS_WOUT + (size_t)j * WOUT_SZ), 32 * nb, 64 * kb, scr, lane);
        return;
    }
    r -= 512;
    {
        const int nblk = 64, kb = r / nblk, nb = r % nblk, n0 = 32 * nb, pn = n0 >> 8, tc = n0 & 255, bj = tc >> 7, jj = tc & 127;
        const float* W = a->in[bj ? 32 : 31] + (size_t)j * DM * DM;
        transpose_item(W, DM, DM, 128 * pn + jj, 32, nullptr, (bf16_t*)(ws + WS_WGLU + (size_t)j * WGLU_SZ), n0, 64 * kb, scr, lane);
    }
}
constexpr int N_CONVERT_ITEMS = 8 * 2816 + 8 * 1408 + 2 * 3200;

__device__ void s5_setup(ArgsP a, int j, int g, int part, LAS unsigned char* lds) {
    const int tid = opaque_tid();
    LAS float* lamp = (LAS float*)lds;
    LAS float* bbar = lamp + 64 * 33 * 2;
    LAS float* cc = bbar + 64 * 16 * 2;
    LAS float* Kt = cc + 16 * 64 * 2;
    const float step = __expf(a->in[25][j * 64 + g]);
    const float* are = a->in[23] + (size_t)(j * 64 + g) * 64; const float* aim = a->in[24] + (size_t)(j * 64 + g) * 64;
    for (int idx = tid; idx < 64 * 33; idx += 512) { const int p = idx / 33, k = idx % 33;
        const float mag = expf((float)k * are[p] * step), ang = (float)k * aim[p] * step; float sn, cs; sincosf(ang, &sn, &cs);
        lamp[idx * 2] = mag * cs; lamp[idx * 2 + 1] = mag * sn; }
    for (int idx = tid; idx < 1024; idx += 512) { const int p = idx >> 4, c = idx & 15;
        const float ar = are[p], ai = aim[p]; const float mag = expf(ar * step); float sn, cs; sincosf(ai * step, &sn, &cs);
        const float lr = mag * cs, li = mag * sn, den = ar * ar + ai * ai;
        const float cr = ((lr - 1.0f) * ar + li * ai) / den, ci = (li * ar - (lr - 1.0f) * ai) / den;
        const float br = a->in[26][((size_t)(j * 64 + g) * 64 + p) * 16 + c], bi = a->in[27][((size_t)(j * 64 + g) * 64 + p) * 16 + c];
        bbar[idx * 2] = cr * br - ci * bi; bbar[idx * 2 + 1] = cr * bi + ci * br;
        const int c2 = idx >> 6, p2 = idx & 63;
        cc[idx * 2] = a->in[28][((size_t)(j * 64 + g) * 16 + c2) * 64 + p2]; cc[idx * 2 + 1] = a->in[29][((size_t)(j * 64 + g) * 16 + c2) * 64 + p2]; }
    __syncthreads();
    {
        const int tau = tid >> 4, c = tid & 15;
        float acc[16];
#pragma unroll
        for (int i = 0; i < 16; ++i) acc[i] = 0.f;
        for (int p = 0; p < 64; ++p) {
            const float cr = cc[(c * 64 + p) * 2], ci = cc[(c * 64 + p) * 2 + 1], lr = lamp[(p * 33 + tau) * 2], li = lamp[(p * 33 + tau) * 2 + 1];
            const float zr = cr * lr - ci * li, zi = cr * li + ci * lr;
#pragma unroll
            for (int i = 0; i < 16; ++i) acc[i] += zr * bbar[(p * 16 + i) * 2] - zi * bbar[(p * 16 + i) * 2 + 1];
        }
#pragma unroll
        for (int i = 0; i < 16; ++i) Kt[tau * 260 + c * 16 + i] = acc[i];
    }
    __syncthreads();
    bf16_t* W1 = (bf16_t*)(a->ws + WS_S5W1) + (size_t)g * 256 * 512;
    for (int ch = tid + 512 * part; ch < 256 * 64; ch += 512 * 3) {
        const int row = ch >> 6, c8 = ch & 63; float v[8];
        if (row < 128) { const int p = row & 63, s = c8 >> 1, c0 = (c8 & 1) * 8; const float lr = lamp[(p * 33 + 31 - s) * 2], li = lamp[(p * 33 + 31 - s) * 2 + 1];
#pragma unroll
            for (int i = 0; i < 8; ++i) { const float br = bbar[(p * 16 + c0 + i) * 2], bi = bbar[(p * 16 + c0 + i) * 2 + 1]; v[i] = row < 64 ? (lr * br - li * bi) : (lr * bi + li * br); } }
        else {
#pragma unroll
            for (int i = 0; i < 8; ++i) v[i] = 0.f; }
        u32x4 o; o.x = cvt_pk_bf16(v[0], v[1]); o.y = cvt_pk_bf16(v[2], v[3]); o.z = cvt_pk_bf16(v[4], v[5]); o.w = cvt_pk_bf16(v[6], v[7]);
        *(u32x4*)(W1 + (size_t)row * 512 + c8 * 8) = o;
    }
    bf16_t* WA = (bf16_t*)(a->ws + WS_S5WA) + (size_t)g * 512 * 640;
    for (int ch = tid + 512 * part; ch < 512 * 80; ch += 512 * 3) {
        const int row = ch / 80, c8 = ch % 80, t = row >> 4, c = row & 15; float v[8];
        if (c8 < 64) { const int s = c8 >> 1, c0 = (c8 & 1) * 8;
#pragma unroll
            for (int i = 0; i < 8; ++i) v[i] = (s <= t) ? Kt[(t - s) * 260 + c * 16 + c0 + i] : 0.f; }
        else { const int pb = (c8 - 64) * 8;
#pragma unroll
            for (int i = 0; i < 8; ++i) { const int pp = pb + i, p = pp & 63; const float cr = cc[(c * 64 + p) * 2], ci = cc[(c * 64 + p) * 2 + 1], lr = lamp[(p * 33 + t + 1) * 2], li = lamp[(p * 33 + t + 1) * 2 + 1];
                v[i] = pp < 64 ? (cr * lr - ci * li) : -(cr * li + ci * lr); } }
        u32x4 o; o.x = cvt_pk_bf16(v[0], v[1]); o.y = cvt_pk_bf16(v[2], v[3]); o.z = cvt_pk_bf16(v[4], v[5]); o.w = cvt_pk_bf16(v[6], v[7]);
        *(u32x4*)(WA + (size_t)row * 640 + c8 * 8) = o;
    }
    __syncthreads();
}

__device__ void s5_build_u(ArgsP a, int layer, LAS unsigned char* lds) {
    const int tid = opaque_tid(), lane = tid & 63, wid = tid >> 6;
    const bf16_t* XB = (const bf16_t*)(a->ws + WS_XB); const float* SS = (const float*)(a->ws + WS_SS);
    bf16_t* UA = (bf16_t*)(a->ws + WS_R + R_UA);
    const float* gain = a->in[5] + layer * DM;
    LAS float* rsl = (LAS float*)(lds + 32 * 2064);
    for (int n = blockIdx.x; n < 1024; n += gridDim.x) {
        const size_t tok0 = (size_t)(n >> 7) * SEQ + (size_t)(n & 127) * 32;
        if (tid < 256) { const int row = tid >> 3, part = tid & 7; const f32x4 v = *(const f32x4*)(SS + (tok0 + row) * 32 + part * 4);
            float s = (v[0] + v[1]) + (v[2] + v[3]); s += swz_xor<1>(s); s += swz_xor<2>(s); s += swz_xor<4>(s);
            if (part == 0) rsl[row] = rsqrtf(s * (1.0f / 1024.0f) + EPS); }
        __syncthreads();
#pragma unroll
        for (int i = 0; i < 8; ++i) { const int id = i * 512 + tid, row = id >> 7, c16 = id & 127;
            const u32x4 w = *(const u32x4*)(XB + (tok0 + row) * DM + c16 * 8); const float r = rsl[row];
            const f32x4 g0 = *(const f32x4*)(gain + c16 * 8), g1 = *(const f32x4*)(gain + c16 * 8 + 4);
            u32x4 o; o.x = cvt_pk_bf16(bf_lo(w.x) * r * g0[0], bf_hi(w.x) * r * g0[1]); o.y = cvt_pk_bf16(bf_lo(w.y) * r * g0[2], bf_hi(w.y) * r * g0[3]);
            o.z = cvt_pk_bf16(bf_lo(w.z) * r * g1[0], bf_hi(w.z) * r * g1[1]); o.w = cvt_pk_bf16(bf_lo(w.w) * r * g1[2], bf_hi(w.w) * r * g1[3]);
            *(LAS u32x4*)(lds + row * 2064 + c16 * 16) = o; }
        __syncthreads();
#pragma unroll
        for (int gg = 0; gg < 8; ++gg) { const int g = wid * 8 + gg, s = lane >> 1, half = lane & 1;
            const u32x4 v = *(const LAS u32x4*)(lds + s * 2064 + g * 32 + half * 16);
            *(u32x4*)(UA + ((size_t)g * 1024 + n) * 640 + lane * 8) = v; }
        __syncthreads();
    }
}

__device__ void s5_scan(ArgsP a, int j) {
    const int gt = blockIdx.x * 512 + opaque_tid();
    if (gt >= 32768) return;
    const int p = gt & 63, g = (gt >> 6) & 63, b = gt >> 12;
    const float step = __expf(a->in[25][j * 64 + g]);
    const float ar = a->in[23][(size_t)(j * 64 + g) * 64 + p], ai = a->in[24][(size_t)(j * 64 + g) * 64 + p];
    const float mag = expf(32.0f * ar * step); float sn, cs; sincosf(32.0f * ai * step, &sn, &cs);
    const float lr = mag * cs, li = mag * sn;
    const float* SST = (const float*)(a->ws + WS_R + R_SST) + ((size_t)g * 1024 + b * 128) * 128;
    bf16_t* UA = (bf16_t*)(a->ws + WS_R + R_UA) + ((size_t)g * 1024 + b * 128) * 640 + 512;
    float xr = 0.f, xi = 0.f;
    float sr[2][16], si[2][16];
#pragma unroll
    for (int i = 0; i < 16; ++i) { sr[0][i] = SST[(size_t)i * 128 + p]; si[0][i] = SST[(size_t)i * 128 + 64 + p]; }
#pragma unroll
    for (int kb = 0; kb < 8; ++kb) {
        const int k0 = kb * 16;
        if (kb + 1 < 8) {
#pragma unroll
            for (int i = 0; i < 16; ++i) { sr[(kb + 1) & 1][i] = SST[(size_t)(k0 + 16 + i) * 128 + p]; si[(kb + 1) & 1][i] = SST[(size_t)(k0 + 16 + i) * 128 + 64 + p]; }
        }
#pragma unroll
        for (int i = 0; i < 16; ++i) {
            UA[(size_t)(k0 + i) * 640 + p] = (bf16_t)(cvt_pk_bf16(xr, 0.f) & 0xffffu); UA[(size_t)(k0 + i) * 640 + 64 + p] = (bf16_t)(cvt_pk_bf16(xi, 0.f) & 0xffffu);
            const float nr = lr * xr - li * xi + sr[kb & 1][i], ni = lr * xi + li * xr + si[kb & 1][i]; xr = nr; xi = ni;
        }
    }
}

__device__ void cumsum_bh(ArgsP a, int bh, LAS unsigned char* lds) {
    const int tid = opaque_tid(), lane = tid & 63, wid = tid >> 6, b = bh >> 3, h = bh & 7;
    const float* LF = (const float*)(a->ws + WS_LF) + ((size_t)b * SEQ + tid * 8) * 8 + h;
    float v[8]; float run = 0.f;
#pragma unroll
    for (int i = 0; i < 8; ++i) { run += LF[i * 8]; v[i] = run; }
    LAS float* tot = (LAS float*)lds;
    tot[tid] = run;
    __syncthreads();
    float off = 0.f;
    for (int u = 0; u < tid; ++u) off += tot[u];
    float* C = (float*)(a->ws + WS_CUM) + (size_t)bh * SEQ + tid * 8;
#pragma unroll
    for (int i = 0; i < 8; ++i) C[i] = (off + v[i]) * LOG2E;
    __syncthreads();
}

__device__ __forceinline__ int crow(int r, int hi) { return (r & 3) + 8 * (r >> 2) + 4 * hi; }
__device__ __forceinline__ void glds16(const void* g, LAS void* l) { __builtin_amdgcn_global_load_lds((const unsigned*)g, (LAS unsigned*)l, 16, 0, 0); }
__device__ __forceinline__ void glds4(const void* g, LAS void* l) { __builtin_amdgcn_global_load_lds((const unsigned*)g, (LAS unsigned*)l, 4, 0, 0); }
__device__ __forceinline__ s16x4 vtr(const LAS char* p) { return __builtin_bit_cast(s16x4, __builtin_amdgcn_ds_read_tr16_b64_v4i16((LAS s16x4*)p)); }

constexpr int AT_STAGE = 32768, AT_CK = 65536, AT_TB = 66048, AT_WSF = 66560, AT_XCH = 68608, AT_MISC = 69632;

struct AttnP { const bf16_t *Q, *K, *V; bf16_t* O; const float* cum; const float* relb; const float* subg; float lam, lam_init, ref_fox, ref_diff; };

template <int NMAP>
__device__ __forceinline__ void attn_unit(LAS unsigned char* lds, const AttnP& P, int b, int h, int qb) {
    const int tid = opaque_tid(), lane = tid & 63, r32 = lane & 31, hi = lane >> 5, wid = __builtin_amdgcn_readfirstlane(tid >> 6);
    constexpr int QROWS = NMAP == 1 ? 256 : 128, ND = NMAP == 1 ? 2 : 4;
    const int q0 = qb * QROWS;
    const int rb = NMAP == 1 ? wid : (wid >> 1), mp = NMAP == 1 ? 0 : (wid & 1);
    const int qw0 = q0 + rb * 32;
    const size_t rowbase = (size_t)b * SEQ;
    const int colqk = NMAP == 1 ? 512 + h * 64 : h * 128;
    const int NT = (q0 + QROWS) >> 6, tl = (qw0 + 31) >> 6;
    const int bh = b * 8 + h;
    LAS float* tb = (LAS float*)(lds + AT_TB);

    float cbase;
    if (NMAP == 2) {
        if (tid < 128) {
            int bk = tid; if (tid >= 16) { bk = 16 + (int)(logf((float)tid * (1.0f / 16.0f)) / 2.0794415416798357f * 16.0f); bk = bk < 31 ? bk : 31; }
            tb[tid] = (P.relb[bk * 4 + h] - P.relb[31 * 4 + h]) * LOG2E;
        }
        float bm = (lane < 32) ? (P.relb[lane * 4 + h] - P.relb[31 * 4 + h]) * LOG2E : 0.f;
        bm = fmaxf(bm, swz_xor<1>(bm)); bm = fmaxf(bm, swz_xor<2>(bm)); bm = fmaxf(bm, swz_xor<4>(bm)); bm = fmaxf(bm, swz_xor<8>(bm)); bm = fmaxf(bm, swz_xor<16>(bm)); bm = red32_max(bm);
        cbase = -(P.ref_diff + bm);
    } else {
        cbase = P.cum[(size_t)bh * SEQ + qw0 + r32] - P.ref_fox;
    }
    bf16x8 qr[4];
#pragma unroll
    for (int d0 = 0; d0 < 4; ++d0) qr[d0] = *(const bf16x8*)(P.Q + (rowbase + qw0 + r32) * DM + colqk + mp * 64 + d0 * 16 + hi * 8);

    auto issue = [&](int t, int st) {
        LAS unsigned char* sb = lds + st * AT_STAGE;
        const bf16_t* kp = P.K + (rowbase + 64 * t + lane) * DM + colqk + wid * 8;
#pragma unroll
        for (int m = 0; m < NMAP; ++m) glds16(kp + m * 64, sb + m * 8192 + wid * 1024);
#pragma unroll
        for (int q = 0; q < NMAP; ++q) { const int pp = wid + 8 * q, dblk = pp >> 2, kvb = pp & 3;
            glds16(P.V + (rowbase + 64 * t + 16 * kvb + (lane >> 2)) * DM + colqk + dblk * 32 + (lane & 3) * 8, sb + 16384 + pp * 1024); }
    };

    f32x16 o[ND], ol = f32x16{}; float lsum = 0.f;
#pragma unroll
    for (int d = 0; d < ND; ++d) o[d] = f32x16{};
    const bf16x8 ones = (bf16x8){0x3f80, 0x3f80, 0x3f80, 0x3f80, 0x3f80, 0x3f80, 0x3f80, 0x3f80};

    issue(0, 0);
    const float* cumrow = P.cum + (size_t)bh * SEQ + lane;
    float ckn = 0.f;
    if (NMAP == 1 && wid == 0) ((LAS float*)(lds + AT_CK))[lane] = cumrow[0];
    for (int t = 0; t < NT; ++t) {
        const int st = t & 1;
        asm volatile("s_waitcnt vmcnt(0)" ::: "memory");
        __syncthreads();
        if (t + 1 < NT) { issue(t + 1, st ^ 1); if (NMAP == 1 && wid == 0) ckn = cumrow[64 * (t + 1)]; }
        if (t <= tl) {
            const LAS char* sb = (const LAS char*)(lds + st * AT_STAGE);
            f32x16 p[2];
            if (NMAP == 1) {
                const LAS float* ck = (const LAS float*)(lds + AT_CK + st * 256);
                const f32x4 c0 = *(const LAS f32x4*)(ck + 4 * hi), c1 = *(const LAS f32x4*)(ck + 4 * hi + 8), c2 = *(const LAS f32x4*)(ck + 4 * hi + 16), c3 = *(const LAS f32x4*)(ck + 4 * hi + 24);
                const f32x4 c4 = *(const LAS f32x4*)(ck + 4 * hi + 32), c5 = *(const LAS f32x4*)(ck + 4 * hi + 40), c6 = *(const LAS f32x4*)(ck + 4 * hi + 48), c7 = *(const LAS f32x4*)(ck + 4 * hi + 56);
                const f32x16 k0 = (f32x16){c0[0], c0[1], c0[2], c0[3], c1[0], c1[1], c1[2], c1[3], c2[0], c2[1], c2[2], c2[3], c3[0], c3[1], c3[2], c3[3]};
                const f32x16 k1 = (f32x16){c4[0], c4[1], c4[2], c4[3], c5[0], c5[1], c5[2], c5[3], c6[0], c6[1], c6[2], c6[3], c7[0], c7[1], c7[2], c7[3]};
                p[0] = cbase - k0; p[1] = cbase - k1;
            } else {
#pragma unroll
                for (int r = 0; r < 16; ++r) { p[0][r] = cbase; p[1][r] = cbase; }
            }
            { const LAS char* kb = sb + mp * 8192 + hi * 1024 + r32 * 16;
#pragma unroll
              for (int d0 = 0; d0 < 4; ++d0) { const bf16x8 b0 = *(const LAS bf16x8*)(kb + d0 * 2048), b1 = *(const LAS bf16x8*)(kb + d0 * 2048 + 512);
                  p[0] = __builtin_amdgcn_mfma_f32_32x32x16_bf16(b0, qr[d0], p[0], 0, 0, 0); p[1] = __builtin_amdgcn_mfma_f32_32x32x16_bf16(b1, qr[d0], p[1], 0, 0, 0); } }
            const int qd = qw0 + r32 - 64 * t - 4 * hi;
            if (NMAP == 2 && (64 * t + 63 + 113 > qw0)) {
                asm volatile("" ::: "memory");
#pragma unroll
                for (int j = 0; j < 8; ++j)
#pragma unroll
                    for (int i = 0; i < 4; ++i) { int n = qd - 8 * j - i; n = n < 0 ? 0 : (n > 127 ? 127 : n); p[j >> 2][4 * (j & 3) + i] += tb[n]; }
            }
            if (64 * t + 63 > qw0) {
                asm volatile("" ::: "memory");
#pragma unroll
                for (int j = 0; j < 8; ++j)
#pragma unroll
                    for (int i = 0; i < 4; ++i) if (8 * j + i > qd) p[j >> 2][4 * (j & 3) + i] = -INFINITY;
            }
#pragma unroll
            for (int r = 0; r < 16; ++r) { p[0][r] = fast_exp2(p[0][r]); p[1][r] = fast_exp2(p[1][r]); }
            if (NMAP == 2) { const f32x16 sv = p[0] + p[1];
                lsum += ((sv[0] + sv[1]) + (sv[2] + sv[3])) + ((sv[4] + sv[5]) + (sv[6] + sv[7])) + ((sv[8] + sv[9]) + (sv[10] + sv[11])) + ((sv[12] + sv[13]) + (sv[14] + sv[15])); }
            bf16x8 pw[4];
#pragma unroll
            for (int ks = 0; ks < 4; ++ks) { const int hp = ks >> 1, bs = 8 * (ks & 1);
                u32x4 w; w.x = cvt_pk_bf16(p[hp][bs + 0], p[hp][bs + 1]); w.y = cvt_pk_bf16(p[hp][bs + 2], p[hp][bs + 3]); w.z = cvt_pk_bf16(p[hp][bs + 4], p[hp][bs + 5]); w.w = cvt_pk_bf16(p[hp][bs + 6], p[hp][bs + 7]);
                pw[ks] = __builtin_bit_cast(bf16x8, w); }
            const LAS char* vp = sb + 16384 + ((lane >> 4) & 1) * 32 + (lane & 3) * 8 + (4 * hi + ((lane & 15) >> 2)) * 64;
            if (NMAP == 1) {
#pragma unroll
                for (int ks = 0; ks < 4; ++ks) ol = __builtin_amdgcn_mfma_f32_32x32x16_bf16(pw[ks], ones, ol, 0, 0, 0);
            }
#pragma unroll
            for (int d = 0; d < ND; ++d)
#pragma unroll
                for (int ks = 0; ks < 4; ++ks) { const s16x4 lo = vtr(vp + d * 4096 + ks * 1024), hh = vtr(vp + d * 4096 + ks * 1024 + 512);
                    const bf16x8 vf = (bf16x8){lo[0], lo[1], lo[2], lo[3], hh[0], hh[1], hh[2], hh[3]};
                    o[d] = __builtin_amdgcn_mfma_f32_32x32x16_bf16(pw[ks], vf, o[d], 0, 0, 0); }
        }
        if (NMAP == 1 && wid == 0 && t + 1 < NT) ((LAS float*)(lds + AT_CK + (st ^ 1) * 256))[lane] = ckn;
    }
    float inv[16];
    if (NMAP == 1) {
#pragma unroll
        for (int r = 0; r < 16; ++r) inv[r] = fast_rcp(ol[r]);
    } else {
        LAS float* wsf = (LAS float*)(lds + AT_WSF) + wid * 32;
        const float lt = red32_add(lsum);
        asm volatile("s_waitcnt lgkmcnt(0)" ::: "memory");
        if (hi == 0) wsf[r32] = fast_rcp(lt);
        asm volatile("s_waitcnt lgkmcnt(0)" ::: "memory");
#pragma unroll
        for (int r = 0; r < 16; ++r) inv[r] = wsf[crow(r, hi)];
        asm volatile("s_waitcnt lgkmcnt(0)" ::: "memory");
    }
    if (NMAP == 1) {
        bf16_t* Ow = P.O + (rowbase + qw0) * DM + 512 + h * 64 + r32;
#pragma unroll
        for (int r = 0; r < 16; ++r)
#pragma unroll
            for (int d = 0; d < ND; ++d) Ow[(size_t)crow(r, hi) * DM + d * 32] = (bf16_t)(cvt_pk_bf16(o[d][r] * inv[r], 0.f) & 0xffffu);
        __syncthreads();
    } else {
        __syncthreads();
        LAS float* xb = (LAS float*)lds + (size_t)rb * (ND * 16 * 64) + lane;
        if (mp == 1) {
#pragma unroll
            for (int d = 0; d < ND; ++d)
#pragma unroll
                for (int r = 0; r < 16; ++r) xb[(d * 16 + r) * 64] = o[d][r] * inv[r];
        }
        __syncthreads();
        if (mp == 0) {
            float ss[16];
#pragma unroll
            for (int r = 0; r < 16; ++r) {
                float s = 0.f;
#pragma unroll
                for (int d = 0; d < ND; ++d) { const float v = o[d][r] * inv[r] - P.lam * xb[(d * 16 + r) * 64]; o[d][r] = v; s += v * v; }
                s += swz_xor<1>(s); s += swz_xor<2>(s); s += swz_xor<4>(s); s += swz_xor<8>(s); s += swz_xor<16>(s);
                ss[r] = rsqrtf(s * (1.0f / 128.0f) + EPS) * (1.0f - P.lam_init);
            }
            bf16_t* Ow = P.O + (rowbase + qw0) * DM + h * 128 + r32;
#pragma unroll
            for (int d = 0; d < ND; ++d) { const float gd = P.subg[d * 32 + r32];
#pragma unroll
                for (int r = 0; r < 16; ++r) Ow[(size_t)crow(r, hi) * DM + d * 32] = (bf16_t)(cvt_pk_bf16(o[d][r] * ss[r] * gd, 0.f) & 0xffffu); }
        }
        __syncthreads();
    }
}

__device__ void attn_phase(ArgsP a, int j, LAS unsigned char* lds) {
    const int tid = opaque_tid(), lane = tid & 63;
    AttnP P;
    P.Q = (const bf16_t*)(a->ws + WS_R + R_Q); P.K = (const bf16_t*)(a->ws + WS_R + R_K); P.V = (const bf16_t*)(a->ws + WS_R + R_V); P.O = (bf16_t*)(a->ws + WS_R + R_Q);
    P.cum = (const float*)(a->ws + WS_CUM); P.relb = a->in[22]; P.subg = a->in[19] + j * 128;
    const float d1 = wave_sum(a->in[15][j * 64 + lane] * a->in[16][j * 64 + lane]), d2 = wave_sum(a->in[17][j * 64 + lane] * a->in[18][j * 64 + lane]);
    {
        float gdq = fabsf(a->in[13][j * 64 + lane]), gdk = fabsf(a->in[14][j * 64 + lane]), gfq = fabsf(a->in[20][j * 64 + lane]), gfk = fabsf(a->in[21][j * 64 + lane]);
#define WMAX(v) v = fmaxf(v, swz_xor<1>(v)); v = fmaxf(v, swz_xor<2>(v)); v = fmaxf(v, swz_xor<4>(v)); v = fmaxf(v, swz_xor<8>(v)); v = fmaxf(v, swz_xor<16>(v)); v = red32_max(v)
        WMAX(gdq); WMAX(gdk); WMAX(gfq); WMAX(gfk);
#undef WMAX
        P.ref_diff = __int_as_float(__builtin_amdgcn_readfirstlane(__float_as_int(64.0f * QSCALE * 1.02f * gdq * gdk)));
        P.ref_fox = __int_as_float(__builtin_amdgcn_readfirstlane(__float_as_int(64.0f * QSCALE * 1.02f * gfq * gfk)));
    }
    const int jo = opaque_s(j);
    const float li_ = (jo == 0) ? 0.2f : 0.47071301821013583f;
    P.lam_init = li_;
    P.lam = __int_as_float(__builtin_amdgcn_readfirstlane(__float_as_int(expf(d1) - expf(d2) + li_)));
    unsigned* ctr = (unsigned*)(a->ws + WS_CTL) + 64 * (1 + j);
    LAS unsigned* misc = (LAS unsigned*)(lds + AT_MISC);
    for (;;) {
        if (tid == 0) misc[0] = atomicAdd(ctr, 1u);
        __syncthreads();
        const int idx = (int)misc[0];
        __syncthreads();
        if (idx >= 2048) break;
        int type, bh, L;
        if (idx < 512) { L = 32 - (idx >> 5); type = 1; bh = idx & 31; }
        else { const int jj = idx - 512; L = 16 - jj / 96; const int r = jj % 96; if (r < 32) { type = 1; bh = r; } else { type = 0; bh = r - 32; } }
        if (type == 0) attn_unit<1>(lds, P, bh >> 3, bh & 7, L - 1);
        else attn_unit<2>(lds, P, bh >> 2, bh & 3, L - 1);
    }
}

#define XB_XCNT(j)  (256  + 64 * (j))
#define XB_XSUB(j)  (1280 + 64 * (j))
#define XB_XGEN(j)  (2304 + 64 * (j))
#define XB_TOP      3328
#define XB_TOPGEN   3392
constexpr int CW_BAR = 4096;
constexpr int LDS_BARST = 131072 + 12288 + 1024 + 256;
__device__ __forceinline__ unsigned xb_ld(unsigned* p)              { return __hip_atomic_load(p, __ATOMIC_RELAXED, __HIP_MEMORY_SCOPE_AGENT); }
__device__ __forceinline__ unsigned xb_add(unsigned* p, unsigned v) { return __hip_atomic_fetch_add(p, v, __ATOMIC_RELAXED, __HIP_MEMORY_SCOPE_AGENT); }
__device__ __forceinline__ unsigned xb_xcc_id() { return (unsigned)__builtin_amdgcn_s_getreg((3 << 11) | 20) & 0xFu; }
#define XB_SPIN(cond) do { unsigned _sp = 0; while (cond) { __builtin_amdgcn_s_sleep(1); if (++_sp > (1u << 24)) break; } } while (0)
__device__ __forceinline__ void grid_barrier(unsigned* ctl, unsigned G) {
    unsigned* bar = ctl + CW_BAR;
    const int tid = opaque_tid();
    asm volatile("s_waitcnt vmcnt(0) lgkmcnt(0)" ::: "memory");
    __syncthreads();
    if (tid == 0) {
        volatile LAS unsigned* st = (volatile LAS unsigned*)((LAS unsigned char*)lds_raw + LDS_BARST);
        const unsigned x = xb_xcc_id();
        unsigned nloc = st[0], nx = st[1];
        if (nloc == 0u) {
            unsigned sum, cnt, mine, sp = 0u;
            for (;;) {
                sum = 0u; cnt = 0u; mine = 0u;
#pragma unroll
                for (unsigned j = 0; j < 16; ++j) { const unsigned c = xb_ld(&bar[XB_XCNT(j)]); sum += c; cnt += (c > 0u) ? 1u : 0u; mine = (j == x) ? c : mine; }
                if (sum == G) break;
                __builtin_amdgcn_s_sleep(1);
                if (++sp > (1u << 22)) break;
            }
            nloc = mine > 0u ? mine : 1u; nx = cnt > 0u ? cnt : 1u; st[0] = nloc; st[1] = nx;
        }
        const unsigned old = xb_add(&bar[XB_XSUB(x)], 1u);
        const unsigned gen = old / nloc;
        if (old + 1u == (gen + 1u) * nloc) {
            __builtin_amdgcn_fence(__ATOMIC_RELEASE, "agent");
            asm volatile("s_waitcnt vmcnt(0)" ::: "memory");
            const unsigned og = xb_add(&bar[XB_TOP], 1u);
            const unsigned tg = og / nx;
            if (og + 1u == (tg + 1u) * nx) xb_add(&bar[XB_TOPGEN], 1u);
            else XB_SPIN(xb_ld(&bar[XB_TOPGEN]) == tg);
            __builtin_amdgcn_fence(__ATOMIC_ACQUIRE, "agent");
            xb_add(&bar[XB_XGEN(x)], 1u);
            asm volatile("s_waitcnt vmcnt(0)" ::: "memory");
        } else {
            XB_SPIN(xb_ld(&bar[XB_XGEN(x)]) == gen);
            __builtin_amdgcn_fence(__ATOMIC_ACQUIRE, "agent");
            asm volatile("s_waitcnt vmcnt(0)" ::: "memory");
        }
    }
    __syncthreads();
}

__global__ void __launch_bounds__(512, 2) fwd_megakernel(Args a_unused) {
    LAS unsigned char* lds = (LAS unsigned char*)lds_raw;
    cg::grid_group grid = cg::this_grid();
    const int G0 = gridDim.x, bx0 = blockIdx.x;
#define G opaque_s(G0)
#define bx opaque_s(bx0)
    LAS float* rs = (LAS float*)(lds + LDS_RS);
    { const int t0 = threadIdx.x; const int key = hw_wave_key(); if ((t0 & 63) == 0) *(volatile LAS int*)(lds + LDS_WIDTAB + key * 4) = t0 >> 6; }
    if (threadIdx.x == 0) { volatile LAS unsigned* st = (volatile LAS unsigned*)(lds + LDS_BARST); st[0] = 0u; st[1] = 0u;
        (void)xb_add((unsigned*)(kargs()->ws + WS_CTL) + CW_BAR + XB_XCNT(xb_xcc_id()), 1u); }
    grid.sync();
#define GRID_SYNC() grid_barrier((unsigned*)(kargs()->ws + WS_CTL), (unsigned)G)

    {
        ArgsP a = kargs();
        const int tid = opaque_tid(), lane = tid & 63, wid = tid >> 6, Gp = G, bxp = bx;
        LAS float* scr = (LAS float*)(lds + wid * 16384);
        const int gw = bxp * 8 + wid, NGW = Gp * 8;
        for (int it = gw; it < N_CONVERT_ITEMS; it += NGW) convert_item(a, it, scr, lane);
        bf16_t* XB = (bf16_t*)(a->ws + WS_XB); float* SS = (float*)(a->ws + WS_SS); const float* xin = a->in[0];
        for (int m = gw; m < MTOK; m += NGW) {
            const f32x4* xr = (const f32x4*)(xin + (size_t)m * DM) + lane;
            u32x2* ob = (u32x2*)(XB + (size_t)m * DM) + lane;
            float s = 0.f;
#pragma unroll
            for (int jx = 0; jx < 4; ++jx) { const f32x4 v = xr[64 * jx]; s += (v[0] * v[0] + v[1] * v[1]) + (v[2] * v[2] + v[3] * v[3]);
                u32x2 w; w.x = cvt_pk_bf16(v[0], v[1]); w.y = cvt_pk_bf16(v[2], v[3]); ob[64 * jx] = w; }
            s = wave_sum(s);
            if (lane < 32) SS[(size_t)m * 32 + lane] = lane == 0 ? s : 0.f;
        }
    }
    GRID_SYNC();

#pragma unroll 1
    for (int layer = 0; layer < 4; ++layer) {
        const int j = layer >> 1;
#pragma unroll 1
        for (int f = 0; f < 2; ++f) {
            if (f == 1) {
                if ((layer & 1) == 0) {
                    {
                        ArgsP a = kargs(); unsigned char* ws = a->ws;
                        {
                            const int t = opaque_tid();
                            if (t < 256) { const int sel = t >> 6, d = t & 63; const float* gp = a->in[sel == 0 ? 13 : (sel == 1 ? 14 : (sel == 2 ? 20 : 21))]; ((LAS float*)(lds + LDS_GT))[t] = gp[j * 64 + d]; }
                        }
                        pg8::Gemm g{(const bf16_t*)(ws + WS_XB), (const bf16_t*)(ws + WS_WIN + (size_t)j * WIN_SZ), DM, DM, DM};
                        pg8::StaticOrder S; S.init(MTOK, 3328, G, bx);
                        compute_rowscale(S, (const float*)(ws + WS_SS), rs);
                        pg8::EpiInProj E{(bf16_t*)(ws + WS_R + R_Q), (float*)(ws + WS_LF), rs, (const LAS float*)(lds + LDS_GT), a->in[12] + j * 8};
                        pg8::gemm_phase(lds, g, S, E);
                    }
                    GRID_SYNC();
                    {
                        ArgsP a = kargs();
                        const int bxp = bx;
                        if (bxp < 64) cumsum_bh(a, bxp, lds);
                        else s5_setup(a, j, (bxp - 64) / 3, (bxp - 64) % 3, lds);
                    }
                    GRID_SYNC();
                    attn_phase(kargs(), j, lds);
                    GRID_SYNC();
                    {
                        ArgsP a = kargs(); unsigned char* ws = a->ws;
                        pg8::Gemm g{(const bf16_t*)(ws + WS_R + R_Q), (const bf16_t*)(ws + WS_WOUT + (size_t)j * WOUT_SZ), DM, DM, DM};
                        pg8::StaticOrder S; S.init(MTOK, DM, G, bx);
                        pg8::EpiResAdd E{nullptr, (bf16_t*)(ws + WS_XB), (float*)(ws + WS_SS), 1.0f};
                        pg8::gemm_phase(lds, g, S, E);
                    }
                    GRID_SYNC();
                } else {
                    s5_build_u(kargs(), layer, lds);
                    GRID_SYNC();
                    {
                        ArgsP a = kargs(); unsigned char* ws = a->ws;
                        pg8::Gemm g{(const bf16_t*)(ws + WS_R + R_UA), (const bf16_t*)(ws + WS_S5W1), 640, 512, 512};
                        pg8::S5StateOrder S{G, bx};
                        pg8::EpiS5State E{(float*)(ws + WS_R + R_SST)};
                        pg8::gemm_phase(lds, g, S, E);
                    }
                    GRID_SYNC();
                    s5_scan(kargs(), j);
                    GRID_SYNC();
                    {
                        ArgsP a = kargs(); unsigned char* ws = a->ws;
                        pg8::Gemm g{(const bf16_t*)(ws + WS_R + R_UA), (const bf16_t*)(ws + WS_S5WA), 640, 640, 640};
                        pg8::S5OutOrder S{G, bx};
                        pg8::EpiS5Out E{(const bf16_t*)(ws + WS_R + R_UA), a->in[30] + j * DM, (bf16_t*)(ws + WS_R + R_Y)};
                        pg8::gemm_phase(lds, g, S, E);
                    }
                    GRID_SYNC();
                    {
                        ArgsP a = kargs(); unsigned char* ws = a->ws;
                        pg8::Gemm g{(const bf16_t*)(ws + WS_R + R_Y), (const bf16_t*)(ws + WS_WGLU + (size_t)j * WGLU_SZ), DM, DM, DM};
                        pg8::StaticOrder S; S.init(MTOK, 2048, G, bx);
                        pg8::EpiGlu E{(bf16_t*)(ws + WS_XB), (float*)(ws + WS_SS)};
                        pg8::gemm_phase(lds, g, S, E);
                    }
                    GRID_SYNC();
                }
            }
            const int mi = layer * 2 + f;
            {
                ArgsP a = kargs(); unsigned char* ws = a->ws;
                pg8::Gemm g{(const bf16_t*)(ws + WS_XB), (const bf16_t*)(ws + WS_WGU + (size_t)mi * WGU_SZ), DM, DM, DM};
                pg8::StaticOrder S; S.init(MTOK, 5632, G, bx);
                compute_rowscale(S, (const float*)(ws + WS_SS), rs);
                pg8::EpiGateUp E{(bf16_t*)(ws + WS_R + R_H), rs};
                pg8::gemm_phase(lds, g, S, E);
            }
            GRID_SYNC();
            {
                ArgsP a = kargs(); unsigned char* ws = a->ws;
                pg8::Gemm g{(const bf16_t*)(ws + WS_R + R_H), (const bf16_t*)(ws + WS_WDN + (size_t)mi * WDN_SZ), FF, FF, FF};
                pg8::StaticOrder S; S.init(MTOK, DM, G, bx);
                pg8::EpiResAdd E{(mi == 7) ? a->out : nullptr, (bf16_t*)(ws + WS_XB), (float*)(ws + WS_SS), 0.5f};
                pg8::gemm_phase(lds, g, S, E);
            }
            GRID_SYNC();
        }
    }
}
#undef G
#undef bx
#undef GRID_SYNC

extern "C" void kernel_launch(void* const* d_in, const int* in_sizes, int n_in, void* d_out, int out_size, void* d_ws, size_t ws_size, hipStream_t stream) {
    static int grid = 0;
    if (grid == 0) {
        if (n_in != 33 || out_size != MTOK * DM || ws_size < WS_END) { fprintf(stderr, "kernel_launch: unexpected shapes (n_in %d out %d ws %zu, need ws >= %zu)\n", n_in, out_size, ws_size, (size_t)WS_END); grid = -1; return; }
        int dev = 0, cus = 0, per_cu = 0;
        hipGetDevice(&dev); hipDeviceGetAttribute(&cus, hipDeviceAttributeMultiprocessorCount, dev);
        hipFuncSetAttribute((const void*)fwd_megakernel, hipFuncAttributeMaxDynamicSharedMemorySize, LDS_BYTES);
        hipOccupancyMaxActiveBlocksPerMultiprocessor(&per_cu, (const void*)fwd_megakernel, 512, LDS_BYTES);
        (void)hipGetLastError();
        if (per_cu < 1) { fprintf(stderr, "kernel_launch: occupancy query says %d blocks/CU\n", per_cu); per_cu = 1; }
        grid = cus;
        if (grid != 256) fprintf(stderr, "kernel_launch: warning: %d CUs (built for 256)\n", grid);
    }
    if (grid < 0) return;
    hipMemsetAsync((char*)d_ws + WS_CTL, 0, 65536, stream);
    Args a{};
    for (int i = 0; i < 33; ++i) a.in[i] = (const float*)d_in[i];
    a.out = (float*)d_out; a.ws = (unsigned char*)d_ws;
    void* args[] = {&a};
    hipError_t e = hipLaunchCooperativeKernel((const void*)fwd_megakernel, dim3(grid), dim3(512), args, LDS_BYTES, stream);
    if (e != hipSuccess) fprintf(stderr, "cooperative launch failed: %s (grid %d)\n", hipGetErrorString(e), grid);
}
```

```cpp
#include <hip/hip_runtime.h>
#include <hip/hip_cooperative_groups.h>
#include <cstdio>
#include <cstdint>
#include <cmath>
namespace cg = cooperative_groups;

#define LAS __attribute__((address_space(3)))
typedef unsigned short bf16_t;
typedef short bf16x8 __attribute__((ext_vector_type(8)));
typedef short s16x4 __attribute__((ext_vector_type(4)));
typedef float f32x4 __attribute__((ext_vector_type(4)));
typedef float f32x16 __attribute__((ext_vector_type(16)));
typedef unsigned u32x4 __attribute__((ext_vector_type(4)));
typedef unsigned u32x2 __attribute__((ext_vector_type(2)));

constexpr int MTOK = 32768, DM = 1024, FF = 2816, SEQ = 4096, NB = 8;
constexpr float EPS = 1e-6f;
constexpr float LOG2E = 1.4426950408889634f;
constexpr float QSCALE = 0.125f * LOG2E;

constexpr size_t MiB = 1u << 20;
constexpr size_t WS_CTL = 0;
constexpr size_t WS_SS = 1 * MiB;
constexpr size_t WS_LF = 5 * MiB;
constexpr size_t WS_CUM = 6 * MiB;
constexpr size_t WS_WGU = 8 * MiB;
constexpr size_t WGU_SZ = (size_t)5632 * 1024 * 2;
constexpr size_t WS_WDN = 96 * MiB;
constexpr size_t WDN_SZ = (size_t)1024 * 2816 * 2;
constexpr size_t WS_WIN = 140 * MiB;
constexpr size_t WIN_SZ = (size_t)3328 * 1024 * 2;
constexpr size_t WS_WOUT = 153 * MiB;
constexpr size_t WOUT_SZ = (size_t)1024 * 1024 * 2;
constexpr size_t WS_WGLU = 157 * MiB;
constexpr size_t WGLU_SZ = (size_t)2048 * 1024 * 2;
constexpr size_t WS_S5W1 = 165 * MiB;
constexpr size_t WS_S5WA = 181 * MiB;
constexpr size_t WS_XB = 221 * MiB;
constexpr size_t WS_R = 285 * MiB;
constexpr size_t WS_END = 477 * MiB;
constexpr size_t R_H = 0;
constexpr size_t R_Q = 0, R_K = 64 * MiB, R_V = 128 * MiB;
constexpr size_t R_UA = 0;
constexpr size_t R_SST = 80 * MiB;
constexpr size_t R_Y = 112 * MiB;

constexpr int LDS_BYTES = 147456;
constexpr int LDS_RS = 131072;
constexpr int LDS_GT = 131072 + 12288;

typedef float f32x2_t __attribute__((ext_vector_type(2))); typedef __bf16 bf16x2_t __attribute__((ext_vector_type(2)));
__device__ __forceinline__ unsigned cvt_pk_bf16(float lo, float hi) { const f32x2_t v = {lo, hi}; const bf16x2_t b = __builtin_convertvector(v, bf16x2_t); return __builtin_bit_cast(unsigned, b); }
__device__ __forceinline__ float bf_lo(unsigned w) { return __uint_as_float(w << 16); }
__device__ __forceinline__ float bf_hi(unsigned w) { return __uint_as_float(w & 0xffff0000u); }
__device__ __forceinline__ float fast_exp2(float x) { return __builtin_amdgcn_exp2f(x); }
__device__ __forceinline__ float fast_rcp(float x) { return __builtin_amdgcn_rcpf(x); }
__device__ __forceinline__ float sigmoidf_(float x) { return fast_rcp(1.0f + fast_exp2(-x * LOG2E)); }
__device__ __forceinline__ float gelu_tanh(float y) { const float z = 1.5957691216057308f * (y + 0.044715f * y * y * y); return y * sigmoidf_(z); }
__device__ __forceinline__ u32x4 pack8(f32x4 a, f32x4 b) { u32x4 w; w.x = cvt_pk_bf16(a[0], a[1]); w.y = cvt_pk_bf16(a[2], a[3]); w.z = cvt_pk_bf16(b[0], b[1]); w.w = cvt_pk_bf16(b[2], b[3]); return w; }

template <int K> __device__ __forceinline__ float swz_xor(float v) { return __int_as_float(__builtin_amdgcn_ds_swizzle(__float_as_int(v), 0x1f | (K << 10))); }
__device__ __forceinline__ float red32_add(float v) { auto rr = __builtin_amdgcn_permlane32_swap(__float_as_uint(v), __float_as_uint(v), false, false); return __uint_as_float(rr[0]) + __uint_as_float(rr[1]); }
__device__ __forceinline__ float red32_max(float v) { auto rr = __builtin_amdgcn_permlane32_swap(__float_as_uint(v), __float_as_uint(v), false, false); return fmaxf(__uint_as_float(rr[0]), __uint_as_float(rr[1])); }
__device__ __forceinline__ float red16_add(float v) { return v + swz_xor<16>(v); }
extern __shared__ __attribute__((aligned(16))) unsigned char lds_raw[];
constexpr int LDS_WIDTAB = 131072 + 12288 + 1024;
__device__ __forceinline__ int opaque_s(int v) { asm volatile("" : "+s"(v)); return v; }
__device__ __forceinline__ int hw_wave_key() { int k; asm volatile("s_getreg_b32 %0, hwreg(HW_REG_HW_ID, 0, 6)" : "=s"(k)); return k & 63; }
__device__ __forceinline__ int opaque_tid() {
    int lane; asm volatile("v_mbcnt_lo_u32_b32 %0, -1, 0\n\tv_mbcnt_hi_u32_b32 %0, -1, %0" : "=v"(lane));
    const int key = hw_wave_key();
    const int wid = __builtin_amdgcn_readfirstlane(*(volatile LAS int*)((LAS unsigned char*)lds_raw + LDS_WIDTAB + key * 4));
    return wid * 64 + lane;
}
namespace pg8 {
constexpr int BM = 256, BK = 64, HALF = 128, HTB = HALF * BK * 2, STAGE_BYTES = 8 * HTB, NXCD = 8, WGM = 8;
__host__ __device__ __forceinline__ int lds_byte(int r, int c) { const int st = (r >> 4) * 2 + (c >> 5), rr = r & 15, cc = c & 31, ob = rr * 64 + cc * 2; return st * 1024 + (ob ^ (((ob >> 9) & 1) << 5)); }
__host__ __device__ __forceinline__ void stage_rc(int b, int& R, int& C) { const int st = b / 1024, sb = b % 1024, swz = sb ^ (((sb >> 9) & 1) << 5); R = (st >> 1) * 16 + swz / 64; C = (st & 1) * 32 + (swz % 64) / 2; }
__host__ __device__ __forceinline__ int perm32(int rho) { const int n = rho >> 4, i = rho & 15; return 8 * (i >> 2) + 4 * n + (i & 3); }

struct Unit { int pm, pn; };
struct Gemm { const bf16_t* A; const bf16_t* Bt; int lda, ldb, K; };

struct StaticOrder {
    int nM, nN, nwg, G, c;
    __device__ void init(int M, int N, int G_, int c_) { nM = M / BM; nN = N / BM; nwg = nM * nN; G = G_; c = c_; }
    __device__ bool next(int i, Unit& u) const {
        const long L = (long)i * G + c; if (L >= nwg) return false;
        int wgid = (int)L; { const int q = nwg / NXCD, r = nwg % NXCD, xcd = wgid % NXCD, off = wgid / NXCD; wgid = (xcd < r ? xcd * (q + 1) : r * (q + 1) + (xcd - r) * q) + off; }
        const int nig = WGM * nN, gid = wgid / nig, fm = gid * WGM, gsz = (nM - fm) < WGM ? (nM - fm) : WGM;
        u.pm = fm + ((wgid % nig) % gsz); u.pn = (wgid % nig) / gsz; return true;
    }
};
struct S5StateOrder {
    int G, c;
    __device__ bool next(int i, Unit& u) const { const int L = i * G + c; if (L >= 256) return false; u.pm = L; u.pn = L >> 2; return true; }
};
struct S5OutOrder {
    int G, c;
    __device__ bool next(int i, Unit& u) const { const int L = i * G + c; if (L >= 512) return false; const int g = L >> 3, r = L & 7; u.pm = 4 * g + (r >> 1); u.pn = 2 * g + (r & 1); return true; }
};

template <class Epi, class Sched>
__device__ __forceinline__ void gemm_phase(LAS unsigned char* lds, const Gemm g, const Sched& S, const Epi& E) {
    const int tid = opaque_tid(), wid = __builtin_amdgcn_readfirstlane(tid >> 6), lane = tid & 63, wr = wid >> 2, wc = wid & 3, fr = lane & 15, fq = lane >> 4;
    const int K = g.K, nt = K / BK;
    unsigned voffA[2], voffB[2];
#pragma unroll
    for (int i = 0; i < 2; ++i) { int R, C; stage_rc(tid * 16 + i * 8192, R, C); const int Rb = Epi::PERM ? ((R & ~31) + perm32(R & 31)) : R;
        voffA[i] = (unsigned)(R * g.lda + C) * 2u; voffB[i] = (unsigned)(Rb * g.ldb + C) * 2u; }
    const size_t kstep = (size_t)(BK * 2);
    const size_t hA = (size_t)HALF * g.lda * 2, hB = (size_t)HALF * g.ldb * 2;
    const size_t tA = 2 * hA, tB = 2 * hB;
    const unsigned ldsw = (unsigned)wid * 1024u;
    const int aoff = lds_byte(wr * 64 + fr, fq * 8), boff = lds_byte(wc * 32 + fr, fq * 8);
#define PG8_SA(b, h) (((b) * 2 + (h)) * HTB)
#define PG8_SB(b, h) ((4 + (b) * 2 + (h)) * HTB)
#define PG8_STAGE(bufoff, gbase, voff) do { _Pragma("unroll") for (int _i = 0; _i < 2; ++_i) \
        __builtin_amdgcn_global_load_lds((const unsigned*)((const char*)(gbase) + (voff)[_i]), (LAS unsigned*)(lds + (bufoff) + ldsw + _i * 8192), 16, 0, 0); } while (0)
#define PG8_LDA(dst, b, h) do { _Pragma("unroll") for (int m = 0; m < 4; ++m) _Pragma("unroll") for (int k = 0; k < 2; ++k) dst[m][k] = *(const LAS bf16x8*)(lds + PG8_SA(b, h) + aoff + m * 2048 + k * 1024); } while (0)
#define PG8_LDB(dst, b, h) do { _Pragma("unroll") for (int n = 0; n < 2; ++n) _Pragma("unroll") for (int k = 0; k < 2; ++k) dst[n][k] = *(const LAS bf16x8*)(lds + PG8_SB(b, h) + boff + n * 2048 + k * 1024); } while (0)
#define PG8_MMA(ai, bj, At, Bt) do { __builtin_amdgcn_s_setprio(1); _Pragma("unroll") for (int m = 0; m < 4; ++m) _Pragma("unroll") for (int n = 0; n < 2; ++n) _Pragma("unroll") for (int k = 0; k < 2; ++k) \
        acc[ai][bj][m][n] = __builtin_amdgcn_mfma_f32_16x16x32_bf16(Bt[n][k], At[m][k], acc[ai][bj][m][n], 0, 0, 0); __builtin_amdgcn_s_setprio(0); } while (0)
#define PG8_WAIT_V(n) asm volatile("s_waitcnt vmcnt(" #n ")" ::: "memory")
#define PG8_WAIT_L(n) asm volatile("s_waitcnt lgkmcnt(" #n ")" ::: "memory")
#define PG8_BAR __builtin_amdgcn_s_barrier()
#define PG8_SCHED __builtin_amdgcn_sched_barrier(0)
    Unit cur, nxt; int ui = 0;
    if (!S.next(0, cur)) return;
    f32x4 acc[2][2][4][2];
#pragma unroll
    for (int a = 0; a < 2; ++a)
#pragma unroll
        for (int b = 0; b < 2; ++b)
#pragma unroll
            for (int m = 0; m < 4; ++m)
#pragma unroll
                for (int n = 0; n < 2; ++n) acc[a][b][m][n] = (f32x4){0.f, 0.f, 0.f, 0.f};
    bf16x8 At[4][2], B0[2][2], B1[2][2];
    const char* cA = (const char*)g.A + (size_t)cur.pm * tA; const char* cB = (const char*)g.Bt + (size_t)cur.pn * tB;
    PG8_STAGE(PG8_SB(0, 0), cB, voffB); PG8_STAGE(PG8_SB(0, 1), cB + hB, voffB); PG8_STAGE(PG8_SA(0, 0), cA, voffA); PG8_STAGE(PG8_SA(0, 1), cA + hA, voffA);
    if (wr == 1) PG8_BAR;
    PG8_WAIT_V(2); PG8_BAR;
    PG8_STAGE(PG8_SB(1, 0), cB + kstep, voffB); PG8_STAGE(PG8_SA(1, 0), cA + kstep, voffA); PG8_STAGE(PG8_SB(1, 1), cB + hB + kstep, voffB);
    PG8_WAIT_V(6); PG8_BAR;
    for (;;) {
        const bool has_next = S.next(ui + 1, nxt);
        const char* nA = has_next ? (const char*)g.A + (size_t)nxt.pm * tA : cA; const char* nB = has_next ? (const char*)g.Bt + (size_t)nxt.pn * tB : cB;
        for (int t = 0; t < nt; t += 2) {
            const bool last = (t == nt - 2);
            const char* a1 = cA + (size_t)(t + 1) * kstep;
            const char* a2 = last ? nA : cA + (size_t)(t + 2) * kstep; const char* b2 = last ? nB : cB + (size_t)(t + 2) * kstep;
            const char* a3 = a2 + kstep; const char* b3 = b2 + kstep;
            PG8_LDB(B0, 0, 0); PG8_LDB(B1, 0, 1); PG8_SCHED; PG8_LDA(At, 0, 0); PG8_STAGE(PG8_SA(1, 1), a1 + hA, voffA);
            PG8_WAIT_V(8); PG8_WAIT_L(0); PG8_BAR; PG8_MMA(0, 0, At, B0); PG8_MMA(0, 1, At, B1); PG8_BAR; PG8_SCHED;
            PG8_LDA(At, 0, 1); PG8_STAGE(PG8_SB(0, 0), b2, voffB); PG8_STAGE(PG8_SB(0, 1), b2 + hB, voffB); PG8_STAGE(PG8_SA(0, 0), a2, voffA);
            PG8_WAIT_V(8); PG8_WAIT_L(0); PG8_BAR; PG8_MMA(1, 0, At, B0); PG8_MMA(1, 1, At, B1); PG8_BAR; PG8_SCHED;
            PG8_LDB(B0, 1, 0); PG8_LDB(B1, 1, 1); PG8_SCHED; PG8_LDA(At, 1, 0); PG8_STAGE(PG8_SA(0, 1), a2 + hA, voffA);
            PG8_WAIT_V(8); PG8_WAIT_L(0); PG8_BAR; PG8_MMA(0, 0, At, B0); PG8_MMA(0, 1, At, B1); PG8_BAR; PG8_SCHED;
            PG8_LDA(At, 1, 1); PG8_STAGE(PG8_SB(1, 0), b3, voffB); PG8_STAGE(PG8_SB(1, 1), b3 + hB, voffB); PG8_STAGE(PG8_SA(1, 0), a3, voffA);
            PG8_WAIT_V(8); PG8_WAIT_L(0); PG8_BAR; PG8_MMA(1, 0, At, B0); PG8_MMA(1, 1, At, B1); PG8_BAR; PG8_SCHED;
        }
        if (wr == 0) PG8_BAR;
        E(acc, cur, ui, wr, wc, fr, fq);
        if (!has_next) break;
#pragma unroll
        for (int a = 0; a < 2; ++a)
#pragma unroll
            for (int b = 0; b < 2; ++b)
#pragma unroll
                for (int m = 0; m < 4; ++m)
#pragma unroll
                    for (int n = 0; n < 2; ++n) acc[a][b][m][n] = (f32x4){0.f, 0.f, 0.f, 0.f};
        cur = nxt; cA = nA; cB = nB; ++ui;
        if (wr == 1) PG8_BAR;
    }
    PG8_WAIT_V(0);
    PG8_BAR;
#undef PG8_SA
#undef PG8_SB
#undef PG8_STAGE
#undef PG8_LDA
#undef PG8_LDB
#undef PG8_MMA
#undef PG8_WAIT_V
#undef PG8_WAIT_L
#undef PG8_BAR
#undef PG8_SCHED
}

typedef f32x4 AccT[2][2][4][2];

struct EpiGateUp {
    static constexpr bool PERM = true;
    bf16_t* H; const LAS float* rs;
    __device__ __forceinline__ void operator()(const AccT& acc, const Unit& u, int ui, int wr, int wc, int fr, int fq) const {
        const int col0 = u.pn * 128 + wc * 32 + 8 * fq;
#pragma unroll
        for (int ai = 0; ai < 2; ++ai)
#pragma unroll
            for (int m = 0; m < 4; ++m) {
                const int rt = ai * 128 + wr * 64 + m * 16 + fr; const float r = rs[ui * 256 + rt];
                f32x4 hv[2];
#pragma unroll
                for (int n = 0; n < 2; ++n) { const f32x4 gv = acc[ai][0][m][n] * r, uv = acc[ai][1][m][n] * r;
#pragma unroll
                    for (int i = 0; i < 4; ++i) hv[n][i] = gv[i] * sigmoidf_(gv[i]) * uv[i]; }
                *(u32x4*)(H + (size_t)(u.pm * 256 + rt) * FF + col0) = pack8(hv[0], hv[1]);
            }
    }
};
struct EpiResAdd {
    static constexpr bool PERM = true;
    float* OUT; bf16_t* XB; float* SS; float scale;
    __device__ __forceinline__ void operator()(const AccT& acc, const Unit& u, int ui, int wr, int wc, int fr, int fq) const {
        const int col0 = u.pn * 256 + wc * 32 + 8 * fq;
#pragma unroll
        for (int ai = 0; ai < 2; ++ai) {
            u32x4 w[4][2];
#pragma unroll
            for (int m = 0; m < 4; ++m)
#pragma unroll
                for (int bj = 0; bj < 2; ++bj) w[m][bj] = *(const u32x4*)(XB + ((size_t)u.pm * 256 + ai * 128 + wr * 64 + m * 16 + fr) * DM + col0 + bj * 128);
#pragma unroll
            for (int m = 0; m < 4; ++m) {
                const size_t row = (size_t)u.pm * 256 + ai * 128 + wr * 64 + m * 16 + fr;
#pragma unroll
                for (int bj = 0; bj < 2; ++bj) {
                    const u32x4 ww = w[m][bj];
                    f32x4 a = (f32x4){bf_lo(ww.x), bf_hi(ww.x), bf_lo(ww.y), bf_hi(ww.y)}, b = (f32x4){bf_lo(ww.z), bf_hi(ww.z), bf_lo(ww.w), bf_hi(ww.w)};
                    a = a + acc[ai][bj][m][0] * scale; b = b + acc[ai][bj][m][1] * scale;
                    if (OUT) { float* op = OUT + row * DM + col0 + bj * 128; *(f32x4*)op = a; *(f32x4*)(op + 4) = b; }
                    else {
                        *(u32x4*)(XB + row * DM + col0 + bj * 128) = pack8(a, b);
                        float ss = (a[0] * a[0] + a[1] * a[1]) + (a[2] * a[2] + a[3] * a[3]) + (b[0] * b[0] + b[1] * b[1]) + (b[2] * b[2] + b[3] * b[3]);
                        ss = red16_add(ss); ss = red32_add(ss);
                        if (fq == 0) SS[row * 32 + u.pn * 8 + bj * 4 + wc] = ss;
                    }
                }
            }
        }
    }
};
struct EpiGlu {
    static constexpr bool PERM = true;
    bf16_t* XB; float* SS;
    __device__ __forceinline__ void operator()(const AccT& acc, const Unit& u, int ui, int wr, int wc, int fr, int fq) const {
        const int col0 = u.pn * 128 + wc * 32 + 8 * fq;
        u32x4 w[2][4];
#pragma unroll
        for (int ai = 0; ai < 2; ++ai)
#pragma unroll
            for (int m = 0; m < 4; ++m) w[ai][m] = *(const u32x4*)(XB + ((size_t)u.pm * 256 + ai * 128 + wr * 64 + m * 16 + fr) * DM + col0);
#pragma unroll
        for (int ai = 0; ai < 2; ++ai)
#pragma unroll
            for (int m = 0; m < 4; ++m) {
                const size_t row = (size_t)u.pm * 256 + ai * 128 + wr * 64 + m * 16 + fr;
                const u32x4 ww = w[ai][m];
                f32x4 a = (f32x4){bf_lo(ww.x), bf_hi(ww.x), bf_lo(ww.y), bf_hi(ww.y)}, b = (f32x4){bf_lo(ww.z), bf_hi(ww.z), bf_lo(ww.w), bf_hi(ww.w)};
#pragma unroll
                for (int i = 0; i < 4; ++i) { a[i] += acc[ai][0][m][0][i] * sigmoidf_(acc[ai][1][m][0][i]); b[i] += acc[ai][0][m][1][i] * sigmoidf_(acc[ai][1][m][1][i]); }
                *(u32x4*)(XB + row * DM + col0) = pack8(a, b);
                float ss = (a[0] * a[0] + a[1] * a[1]) + (a[2] * a[2] + a[3] * a[3]) + (b[0] * b[0] + b[1] * b[1]) + (b[2] * b[2] + b[3] * b[3]);
                ss = red16_add(ss); ss = red32_add(ss);
                if (fq == 0) SS[row * 32 + u.pn * 4 + wc] = ss;
            }
    }
};
struct EpiInProj {
    static constexpr bool PERM = true;
    bf16_t* QKV; float* LF; const LAS float* rs; const LAS float* gt; const float* fgb;
    __device__ __forceinline__ void operator()(const AccT& acc, const Unit& u, int ui, int wr, int wc, int fr, int fq) const {
        if (u.pn == 12) {
            if (wc == 0 && fq == 0) {
                const f32x4 b0 = *(const f32x4*)fgb, b1 = *(const f32x4*)(fgb + 4);
#pragma unroll
                for (int ai = 0; ai < 2; ++ai)
#pragma unroll
                    for (int m = 0; m < 4; ++m) {
                        const int rt = ai * 128 + wr * 64 + m * 16 + fr; const float r = rs[ui * 256 + rt];
                        f32x4 z0 = acc[ai][0][m][0] * r + b0, z1 = acc[ai][0][m][1] * r + b1;
#pragma unroll
                        for (int i = 0; i < 4; ++i) {
                            z0[i] = fminf(z0[i], 0.f) - __builtin_amdgcn_logf(1.0f + fast_exp2(-fabsf(z0[i]) * LOG2E)) * 0.6931471805599453f;
                            z1[i] = fminf(z1[i], 0.f) - __builtin_amdgcn_logf(1.0f + fast_exp2(-fabsf(z1[i]) * LOG2E)) * 0.6931471805599453f; }
                        float* lp = LF + (size_t)(u.pm * 256 + rt) * 8; *(f32x4*)lp = z0; *(f32x4*)(lp + 4) = z1;
                    }
            }
            return;
        }
        const int sl = 4 * u.pn + wc, region = sl >> 3, within = sl & 7, kind = region % 3;
        const int colbase = (region >= 3 ? 512 : 0) + within * 64 + 8 * fq;
        bf16_t* dst = QKV + (size_t)kind * ((size_t)MTOK * DM);
        const int gsel = (region >= 3 ? 2 : 0) + (kind == 1 ? 1 : 0);
        f32x4 gn[2][2];
#pragma unroll
        for (int bj = 0; bj < 2; ++bj)
#pragma unroll
            for (int n = 0; n < 2; ++n) gn[bj][n] = *(const LAS f32x4*)(gt + gsel * 64 + 32 * bj + 8 * fq + 4 * n);
        const bool isv = (kind == 2);
        const float qs = kind == 0 ? QSCALE : 1.0f;
#pragma unroll
        for (int ai = 0; ai < 2; ++ai)
#pragma unroll
            for (int m = 0; m < 4; ++m) {
                const int rt = ai * 128 + wr * 64 + m * 16 + fr; const float r = rs[ui * 256 + rt];
                f32x4 v[2][2]; float ss = 0.f;
#pragma unroll
                for (int bj = 0; bj < 2; ++bj)
#pragma unroll
                    for (int n = 0; n < 2; ++n) { v[bj][n] = acc[ai][bj][m][n] * r; const f32x4 x = v[bj][n]; ss += (x[0] * x[0] + x[1] * x[1]) + (x[2] * x[2] + x[3] * x[3]); }
                ss = red16_add(ss); ss = red32_add(ss);
                const float rn = isv ? 1.0f : rsqrtf(ss * (1.0f / 64.0f) + EPS) * qs;
                bf16_t* rowp = dst + (size_t)(u.pm * 256 + rt) * DM + colbase;
#pragma unroll
                for (int bj = 0; bj < 2; ++bj) { f32x4 x0 = v[bj][0] * rn, x1 = v[bj][1] * rn; if (!isv) { x0 = x0 * gn[bj][0]; x1 = x1 * gn[bj][1]; } *(u32x4*)(rowp + 32 * bj) = pack8(x0, x1); }
            }
    }
};
struct EpiS5State {
    static constexpr bool PERM = true;
    float* SST;
    __device__ __forceinline__ void operator()(const AccT& acc, const Unit& u, int ui, int wr, int wc, int fr, int fq) const {
#pragma unroll
        for (int ai = 0; ai < 2; ++ai)
#pragma unroll
            for (int m = 0; m < 4; ++m) {
                const size_t row = (size_t)u.pm * 256 + ai * 128 + wr * 64 + m * 16 + fr;
                float* p = SST + row * 128 + wc * 32 + 8 * fq;
                *(f32x4*)p = acc[ai][0][m][0]; *(f32x4*)(p + 4) = acc[ai][0][m][1];
            }
    }
};
struct EpiS5Out {
    static constexpr bool PERM = true;
    const bf16_t* UA; const float* dsk; bf16_t* Y;
    __device__ __forceinline__ void operator()(const AccT& acc, const Unit& u, int ui, int wr, int wc, int fr, int fq) const {
        const int g = u.pm >> 2;
        f32x4 dv[2][2];
#pragma unroll
        for (int bj = 0; bj < 2; ++bj) { const int c0 = ((u.pn & 1) * 256 + bj * 128 + wc * 32 + 8 * fq) & 15; dv[bj][0] = *(const f32x4*)(dsk + g * 16 + c0); dv[bj][1] = *(const f32x4*)(dsk + g * 16 + c0 + 4); }
#pragma unroll
        for (int ai = 0; ai < 2; ++ai) {
            u32x4 uw[4][2];
#pragma unroll
            for (int m = 0; m < 4; ++m)
#pragma unroll
                for (int bj = 0; bj < 2; ++bj) uw[m][bj] = *(const u32x4*)(UA + (size_t)(u.pm * 256 + ai * 128 + wr * 64 + m * 16 + fr) * 640 + (u.pn & 1) * 256 + bj * 128 + wc * 32 + 8 * fq);
#pragma unroll
            for (int m = 0; m < 4; ++m) {
                const int row = u.pm * 256 + ai * 128 + wr * 64 + m * 16 + fr;
                const int n_ = row & 1023, b = n_ >> 7, k = n_ & 127;
#pragma unroll
                for (int bj = 0; bj < 2; ++bj) {
                    const int col8 = (u.pn & 1) * 256 + bj * 128 + wc * 32 + 8 * fq, t = col8 >> 4, c0 = col8 & 15;
                    const u32x4 w = uw[m][bj]; const f32x4 d0 = dv[bj][0], d1 = dv[bj][1];
                    f32x4 y0, y1;
                    y0[0] = acc[ai][bj][m][0][0] + d0[0] * bf_lo(w.x); y0[1] = acc[ai][bj][m][0][1] + d0[1] * bf_hi(w.x);
                    y0[2] = acc[ai][bj][m][0][2] + d0[2] * bf_lo(w.y); y0[3] = acc[ai][bj][m][0][3] + d0[3] * bf_hi(w.y);
                    y1[0] = acc[ai][bj][m][1][0] + d1[0] * bf_lo(w.z); y1[1] = acc[ai][bj][m][1][1] + d1[1] * bf_hi(w.z);
                    y1[2] = acc[ai][bj][m][1][2] + d1[2] * bf_lo(w.w); y1[3] = acc[ai][bj][m][1][3] + d1[3] * bf_hi(w.w);
#pragma unroll
                    for (int i = 0; i < 4; ++i) { y0[i] = gelu_tanh(y0[i]); y1[i] = gelu_tanh(y1[i]); }
                    *(u32x4*)(Y + ((size_t)b * SEQ + k * 32 + t) * DM + g * 16 + c0) = pack8(y0, y1);
                }
            }
        }
    }
};
}

struct Args { const float* in[33]; float* out; unsigned char* ws; };
typedef const __attribute__((address_space(4))) Args* ArgsP;
__device__ __forceinline__ ArgsP kargs() { ArgsP p = (ArgsP)__builtin_amdgcn_kernarg_segment_ptr(); asm volatile("" : "+s"(p)); return p; }

__device__ __forceinline__ float wave_sum(float v) {
    v += swz_xor<1>(v); v += swz_xor<2>(v); v += swz_xor<4>(v); v += swz_xor<8>(v); v += swz_xor<16>(v);
    return red32_add(v);
}

template <class Sched>
__device__ __forceinline__ void compute_rowscale(const Sched& S, const float* SS, LAS float* rs) {
    const int t = opaque_tid(), row = t >> 1, half = t & 1;
    pg8::Unit u;
    for (int ui = 0; S.next(ui, u); ++ui) {
        const float* p = SS + ((size_t)u.pm * 256 + row) * 32 + half * 16;
        const f32x4 a = *(const f32x4*)p, b = *(const f32x4*)(p + 4), c = *(const f32x4*)(p + 8), d = *(const f32x4*)(p + 12);
        float s = ((a[0] + a[1]) + (a[2] + a[3])) + ((b[0] + b[1]) + (b[2] + b[3])) + ((c[0] + c[1]) + (c[2] + c[3])) + ((d[0] + d[1]) + (d[2] + d[3]));
        s += swz_xor<1>(s);
        if (half == 0) rs[ui * 256 + row] = rsqrtf(s * (1.0f / 1024.0f) + EPS);
    }
    __syncthreads();
}

__device__ __forceinline__ void transpose_item(const float* W, int K, int srcN, int c0, int nvalid, const float* gain, bf16_t* WT, int n0, int k0, LAS float* scr, int lane) {
    const int cc = (lane & 7) * 4, r0 = lane >> 3;
    f32x4 v[8];
#pragma unroll
    for (int i = 0; i < 8; ++i) { const int kk = r0 + 8 * i; v[i] = (cc < nvalid) ? *(const f32x4*)(W + (size_t)(k0 + kk) * srcN + c0 + cc) : (f32x4){0.f, 0.f, 0.f, 0.f}; }
#pragma unroll
    for (int i = 0; i < 8; ++i) { const int kk = r0 + 8 * i; const float g = gain ? gain[k0 + kk] : 1.0f;
        LAS float* d = scr + kk * 33 + cc; d[0] = v[i][0] * g; d[1] = v[i][1] * g; d[2] = v[i][2] * g; d[3] = v[i][3] * g; }
    asm volatile("s_waitcnt lgkmcnt(0)" ::: "memory");
    const int c = lane & 7;
#pragma unroll
    for (int j = 0; j < 4; ++j) { const int n = (lane >> 3) + 8 * j; const LAS float* s = scr + (8 * c) * 33 + n;
        u32x4 o; o.x = cvt_pk_bf16(s[0 * 33], s[1 * 33]); o.y = cvt_pk_bf16(s[2 * 33], s[3 * 33]); o.z = cvt_pk_bf16(s[4 * 33], s[5 * 33]); o.w = cvt_pk_bf16(s[6 * 33], s[7 * 33]);
        *(u32x4*)(WT + (size_t)(n0 + n) * K + k0 + 8 * c) = o; }
    asm volatile("s_waitcnt lgkmcnt(0)" ::: "memory");
}

__device__ __forceinline__ void convert_item(ArgsP a, int it, LAS float* scr, int lane) {
    unsigned char* ws = a->ws;
    if (it < 8 * 2816) {
        const int mi = it / 2816, r = it % 2816, l = mi >> 1, f = mi & 1;
        const int nblk = 5632 / 32, kb = r / nblk, nb = r % nblk, n0 = 32 * nb, pn = n0 >> 8, tc = n0 & 255, bj = tc >> 7, j = tc & 127;
        const float* W = (bj ? a->in[f ? 8 : 3] : a->in[f ? 7 : 2]) + (size_t)l * DM * FF;
        const float* gain = a->in[f ? 6 : 1] + l * DM;
        transpose_item(W, DM, FF, 128 * pn + j, 32, gain, (bf16_t*)(ws + WS_WGU + (size_t)mi * WGU_SZ), n0, 64 * kb, scr, lane);
        return;
    }
    it -= 8 * 2816;
    if (it < 8 * 1408) {
        const int mi = it / 1408, r = it % 1408, l = mi >> 1, f = mi & 1;
        const int nblk = 32, kb = r / nblk, nb = r % nblk;
        const float* W = a->in[f ? 9 : 4] + (size_t)l * FF * DM;
        transpose_item(W, FF, DM, 32 * nb, 32, nullptr, (bf16_t*)(ws + WS_WDN + (size_t)mi * WDN_SZ), 32 * nb, 64 * kb, scr, lane);
        return;
    }
    it -= 8 * 1408;
    const int j = it / 3200; int r = it % 3200;
    if (r < 1664) {
        const int nblk = 104, kb = r / nblk, nb = r % nblk, n0 = 32 * nb, pn = n0 >> 8, tc = n0 & 255;
        int c0, nvalid;
        if (pn < 12) { const int bj = tc >> 7, wc = (tc & 127) >> 5; c0 = (4 * pn + wc) * 64 + 32 * bj; nvalid = 32; }
        else { c0 = 3072; nvalid = (tc == 0) ? 8 : 0; }
        transpose_item(a->in[10] + (size_t)j * DM * 3080, DM, 3080, c0, nvalid, a->in[5] + (2 * j) * DM, (bf16_t*)(ws + WS_WIN + (size_t)j * WIN_SZ), n0, 64 * kb, scr, lane);
        return;
    }
    r -= 1664;
    if (r < 512) {
        const int nblk = 32, kb = r / nblk, nb = r % nblk;
        transpose_item(a->in[11] + (size_t)j * DM * DM, DM, DM, 32 * nb, 32, nullptr, (bf16_t*)(ws + WS_WOUT + (size_t)j * WOUT_SZ), 32 * nb, 64 * kb, scr, lane);
        return;
    }
    r -= 512;
    {
        const int nblk = 64, kb = r / nblk, nb = r % nblk, n0 = 32 * nb, pn = n0 >> 8, tc = n0 & 255, bj = tc >> 7, jj = tc & 127;
        const float* W = a->in[bj ? 32 : 31] + (size_t)j * DM * DM;
        transpose_item(W, DM, DM, 128 * pn + jj, 32, nullptr, (bf16_t*)(ws + WS_WGLU + (size_t)j * WGLU_SZ), n0, 64 * kb, scr, lane);
    }
}
constexpr int N_CONVERT_ITEMS = 8 * 2816 + 8 * 1408 + 2 * 3200;

__device__ void s5_setup(ArgsP a, int j, int g, int part, LAS unsigned char* lds) {
    const int tid = opaque_tid();
    LAS float* lamp = (LAS float*)lds;
    LAS float* bbar = lamp + 64 * 33 * 2;
    LAS float* cc = bbar + 64 * 16 * 2;
    LAS float* Kt = cc + 16 * 64 * 2;
    const float step = __expf(a->in[25][j * 64 + g]);
    const float* are = a->in[23] + (size_t)(j * 64 + g) * 64; const float* aim = a->in[24] + (size_t)(j * 64 + g) * 64;
    for (int idx = tid; idx < 64 * 33; idx += 512) { const int p = idx / 33, k = idx % 33;
        const float mag = expf((float)k * are[p] * step), ang = (float)k * aim[p] * step; float sn, cs; sincosf(ang, &sn, &cs);
        lamp[idx * 2] = mag * cs; lamp[idx * 2 + 1] = mag * sn; }
    for (int idx = tid; idx < 1024; idx += 512) { const int p = idx >> 4, c = idx & 15;
        const float ar = are[p], ai = aim[p]; const float mag = expf(ar * step); float sn, cs; sincosf(ai * step, &sn, &cs);
        const float lr = mag * cs, li = mag * sn, den = ar * ar + ai * ai;
        const float cr = ((lr - 1.0f) * ar + li * ai) / den, ci = (li * ar - (lr - 1.0f) * ai) / den;
        const float br = a->in[26][((size_t)(j * 64 + g) * 64 + p) * 16 + c], bi = a->in[27][((size_t)(j * 64 + g) * 64 + p) * 16 + c];
        bbar[idx * 2] = cr * br - ci * bi; bbar[idx * 2 + 1] = cr * bi + ci * br;
        const int c2 = idx >> 6, p2 = idx & 63;
        cc[idx * 2] = a->in[28][((size_t)(j * 64 + g) * 16 + c2) * 64 + p2]; cc[idx * 2 + 1] = a->in[29][((size_t)(j * 64 + g) * 16 + c2) * 64 + p2]; }
    __syncthreads();
    {
        const int tau = tid >> 4, c = tid & 15;
        float acc[16];
#pragma unroll
        for (int i = 0; i < 16; ++i) acc[i] = 0.f;
        for (int p = 0; p < 64; ++p) {
            const float cr = cc[(c * 64 + p) * 2], ci = cc[(c * 64 + p) * 2 + 1], lr = lamp[(p * 33 + tau) * 2], li = lamp[(p * 33 + tau) * 2 + 1];
            const float zr = cr * lr - ci * li, zi = cr * li + ci * lr;
#pragma unroll
            for (int i = 0; i < 16; ++i) acc[i] += zr * bbar[(p * 16 + i) * 2] - zi * bbar[(p * 16 + i) * 2 + 1];
        }
#pragma unroll
        for (int i = 0; i < 16; ++i) Kt[tau * 260 + c * 16 + i] = acc[i];
    }
    __syncthreads();
    bf16_t* W1 = (bf16_t*)(a->ws + WS_S5W1) + (size_t)g * 256 * 512;
    for (int ch = tid + 512 * part; ch < 256 * 64; ch += 512 * 3) {
        const int row = ch >> 6, c8 = ch & 63; float v[8];
        if (row < 128) { const int p = row & 63, s = c8 >> 1, c0 = (c8 & 1) * 8; const float lr = lamp[(p * 33 + 31 - s) * 2], li = lamp[(p * 33 + 31 - s) * 2 + 1];
#pragma unroll
            for (int i = 0; i < 8; ++i) { const float br = bbar[(p * 16 + c0 + i) * 2], bi = bbar[(p * 16 + c0 + i) * 2 + 1]; v[i] = row < 64 ? (lr * br - li * bi) : (lr * bi + li * br); } }
        else {
#pragma unroll
            for (int i = 0; i < 8; ++i) v[i] = 0.f; }
        u32x4 o; o.x = cvt_pk_bf16(v[0], v[1]); o.y = cvt_pk_bf16(v[2], v[3]); o.z = cvt_pk_bf16(v[4], v[5]); o.w = cvt_pk_bf16(v[6], v[7]);
        *(u32x4*)(W1 + (size_t)row * 512 + c8 * 8) = o;
    }
    bf16_t* WA = (bf16_t*)(a->ws + WS_S5WA) + (size_t)g * 512 * 640;
    for (int ch = tid + 512 * part; ch < 512 * 80; ch += 512 * 3) {
        const int row = ch / 80, c8 = ch % 80, t = row >> 4, c = row & 15; float v[8];
        if (c8 < 64) { const int s = c8 >> 1, c0 = (c8 & 1) * 8;
#pragma unroll
            for (int i = 0; i < 8; ++i) v[i] = (s <= t) ? Kt[(t - s) * 260 + c * 16 + c0 + i] : 0.f; }
        else { const int pb = (c8 - 64) * 8;
#pragma unroll
            for (int i = 0; i < 8; ++i) { const int pp = pb + i, p = pp & 63; const float cr = cc[(c * 64 + p) * 2], ci = cc[(c * 64 + p) * 2 + 1], lr = lamp[(p * 33 + t + 1) * 2], li = lamp[(p * 33 + t + 1) * 2 + 1];
                v[i] = pp < 64 ? (cr * lr - ci * li) : -(cr * li + ci * lr); } }
        u32x4 o; o.x = cvt_pk_bf16(v[0], v[1]); o.y = cvt_pk_bf16(v[2], v[3]); o.z = cvt_pk_bf16(v[4], v[5]); o.w = cvt_pk_bf16(v[6], v[7]);
        *(u32x4*)(WA + (size_t)row * 640 + c8 * 8) = o;
    }
    __syncthreads();
}

__device__ void s5_build_u(ArgsP a, int layer, LAS unsigned char* lds) {
    const int tid = opaque_tid(), lane = tid & 63, wid = tid >> 6;
    const bf16_t* XB = (const bf16_t*)(a->ws + WS_XB); const float* SS = (const float*)(a->ws + WS_SS);
    bf16_t* UA = (bf16_t*)(a->ws + WS_R + R_UA);
    const float* gain = a->in[5] + layer * DM;
    LAS float* rsl = (LAS float*)(lds + 32 * 2064);
    u32x4 xw[8]; f32x4 sv = (f32x4){0.f, 0.f, 0.f, 0.f};
    int n = blockIdx.x;
    if (n < 1024) { const size_t tok0 = (size_t)(n >> 7) * SEQ + (size_t)(n & 127) * 32;
        if (tid < 256) sv = *(const f32x4*)(SS + (tok0 + (tid >> 3)) * 32 + (tid & 7) * 4);
#pragma unroll
        for (int i = 0; i < 8; ++i) { const int id = i * 512 + tid; xw[i] = *(const u32x4*)(XB + (tok0 + (id >> 7)) * DM + (id & 127) * 8); } }
    while (n < 1024) {
        if (tid < 256) { const int row = tid >> 3, part = tid & 7;
            float s_ = (sv[0] + sv[1]) + (sv[2] + sv[3]); s_ += swz_xor<1>(s_); s_ += swz_xor<2>(s_); s_ += swz_xor<4>(s_);
            if (part == 0) rsl[row] = rsqrtf(s_ * (1.0f / 1024.0f) + EPS); }
        __syncthreads();
#pragma unroll
        for (int i = 0; i < 8; ++i) { const int id = i * 512 + tid, row = id >> 7, c16 = id & 127;
            const u32x4 w = xw[i]; const float r = rsl[row];
            const f32x4 g0 = *(const f32x4*)(gain + c16 * 8), g1 = *(const f32x4*)(gain + c16 * 8 + 4);
            u32x4 o; o.x = cvt_pk_bf16(bf_lo(w.x) * r * g0[0], bf_hi(w.x) * r * g0[1]); o.y = cvt_pk_bf16(bf_lo(w.y) * r * g0[2], bf_hi(w.y) * r * g0[3]);
            o.z = cvt_pk_bf16(bf_lo(w.z) * r * g1[0], bf_hi(w.z) * r * g1[1]); o.w = cvt_pk_bf16(bf_lo(w.w) * r * g1[2], bf_hi(w.w) * r * g1[3]);
            *(LAS u32x4*)(lds + row * 2064 + c16 * 16) = o; }
        const int nn = n + (int)gridDim.x;
        if (nn < 1024) { const size_t tok1 = (size_t)(nn >> 7) * SEQ + (size_t)(nn & 127) * 32;
            if (tid < 256) sv = *(const f32x4*)(SS + (tok1 + (tid >> 3)) * 32 + (tid & 7) * 4);
#pragma unroll
            for (int i = 0; i < 8; ++i) { const int id = i * 512 + tid; xw[i] = *(const u32x4*)(XB + (tok1 + (id >> 7)) * DM + (id & 127) * 8); } }
        __syncthreads();
#pragma unroll
        for (int gg = 0; gg < 8; ++gg) { const int g = wid * 8 + gg, s2 = lane >> 1, half = lane & 1;
            const u32x4 v = *(const LAS u32x4*)(lds + s2 * 2064 + g * 32 + half * 16);
            *(u32x4*)(UA + ((size_t)g * 1024 + n) * 640 + lane * 8) = v; }
        __syncthreads();
        n = nn;
    }
}

__device__ void s5_scan(ArgsP a, int j) {
    const int gt = blockIdx.x * 512 + opaque_tid();
    if (gt >= 32768) return;
    const int p = gt & 63, g = (gt >> 6) & 63, b = gt >> 12;
    const float step = __expf(a->in[25][j * 64 + g]);
    const float ar = a->in[23][(size_t)(j * 64 + g) * 64 + p], ai = a->in[24][(size_t)(j * 64 + g) * 64 + p];
    const float mag = expf(32.0f * ar * step); float sn, cs; sincosf(32.0f * ai * step, &sn, &cs);
    const float lr = mag * cs, li = mag * sn;
    const float* SST = (const float*)(a->ws + WS_R + R_SST) + ((size_t)g * 1024 + b * 128) * 128;
    bf16_t* UA = (bf16_t*)(a->ws + WS_R + R_UA) + ((size_t)g * 1024 + b * 128) * 640 + 512;
    float xr = 0.f, xi = 0.f;
    float sr[2][16], si[2][16];
#pragma unroll
    for (int i = 0; i < 16; ++i) { sr[0][i] = SST[(size_t)i * 128 + p]; si[0][i] = SST[(size_t)i * 128 + 64 + p]; }
#pragma unroll
    for (int kb = 0; kb < 8; ++kb) {
        const int k0 = kb * 16;
        if (kb + 1 < 8) {
#pragma unroll
            for (int i = 0; i < 16; ++i) { sr[(kb + 1) & 1][i] = SST[(size_t)(k0 + 16 + i) * 128 + p]; si[(kb + 1) & 1][i] = SST[(size_t)(k0 + 16 + i) * 128 + 64 + p]; }
        }
#pragma unroll
        for (int i = 0; i < 16; ++i) {
            UA[(size_t)(k0 + i) * 640 + p] = (bf16_t)(cvt_pk_bf16(xr, 0.f) & 0xffffu); UA[(size_t)(k0 + i) * 640 + 64 + p] = (bf16_t)(cvt_pk_bf16(xi, 0.f) & 0xffffu);
            const float nr = lr * xr - li * xi + sr[kb & 1][i], ni = lr * xi + li * xr + si[kb & 1][i]; xr = nr; xi = ni;
        }
    }
}

__device__ void cumsum_bh(ArgsP a, int bh, LAS unsigned char* lds) {
    const int tid = opaque_tid(), lane = tid & 63, wid = tid >> 6, b = bh >> 3, h = bh & 7;
    const float* LF = (const float*)(a->ws + WS_LF) + ((size_t)b * SEQ + tid * 8) * 8 + h;
    float v[8]; float run = 0.f;
#pragma unroll
    for (int i = 0; i < 8; ++i) { run += LF[i * 8]; v[i] = run; }
    LAS float* tot = (LAS float*)lds;
    tot[tid] = run;
    __syncthreads();
    float off = 0.f;
    for (int u = 0; u < tid; ++u) off += tot[u];
    float* C = (float*)(a->ws + WS_CUM) + (size_t)bh * SEQ + tid * 8;
#pragma unroll
    for (int i = 0; i < 8; ++i) C[i] = (off + v[i]) * LOG2E;
    __syncthreads();
}

__device__ __forceinline__ int crow(int r, int hi) { return (r & 3) + 8 * (r >> 2) + 4 * hi; }
__device__ __forceinline__ void glds16(const void* g, LAS void* l) { __builtin_amdgcn_global_load_lds((const unsigned*)g, (LAS unsigned*)l, 16, 0, 0); }
__device__ __forceinline__ void glds4(const void* g, LAS void* l) { __builtin_amdgcn_global_load_lds((const unsigned*)g, (LAS unsigned*)l, 4, 0, 0); }
__device__ __forceinline__ s16x4 vtr(const LAS char* p) { return __builtin_bit_cast(s16x4, __builtin_amdgcn_ds_read_tr16_b64_v4i16((LAS s16x4*)p)); }

constexpr int AT_STAGE = 32768, AT_CK = 65536, AT_TB = 66048, AT_WSF = 66560, AT_XCH = 68608, AT_MISC = 69632;

struct AttnP { const bf16_t *Q, *K, *V; bf16_t* O; const float* cum; const float* relb; const float* subg; float lam, lam_init, ref_fox, ref_diff; };

template <int NMAP>
__device__ __forceinline__ void attn_unit(LAS unsigned char* lds, const AttnP& P, int b, int h, int qb) {
    const int tid = opaque_tid(), lane = tid & 63, r32 = lane & 31, hi = lane >> 5, wid = __builtin_amdgcn_readfirstlane(tid >> 6);
    constexpr int QROWS = NMAP == 1 ? 256 : 128, ND = NMAP == 1 ? 2 : 4;
    const int q0 = qb * QROWS;
    const int rb = NMAP == 1 ? wid : (wid >> 1), mp = NMAP == 1 ? 0 : (wid & 1);
    const int qw0 = q0 + rb * 32;
    const size_t rowbase = (size_t)b * SEQ;
    const int colqk = NMAP == 1 ? 512 + h * 64 : h * 128;
    const int NT = (q0 + QROWS) >> 6, tl = (qw0 + 31) >> 6;
    const int bh = b * 8 + h;
    LAS float* tb = (LAS float*)(lds + AT_TB);

    float cbase;
    if (NMAP == 2) {
        if (tid < 128) {
            int bk = tid; if (tid >= 16) { bk = 16 + (int)(logf((float)tid * (1.0f / 16.0f)) / 2.0794415416798357f * 16.0f); bk = bk < 31 ? bk : 31; }
            tb[tid] = (P.relb[bk * 4 + h] - P.relb[31 * 4 + h]) * LOG2E;
        }
        float bm = (lane < 32) ? (P.relb[lane * 4 + h] - P.relb[31 * 4 + h]) * LOG2E : 0.f;
        bm = fmaxf(bm, swz_xor<1>(bm)); bm = fmaxf(bm, swz_xor<2>(bm)); bm = fmaxf(bm, swz_xor<4>(bm)); bm = fmaxf(bm, swz_xor<8>(bm)); bm = fmaxf(bm, swz_xor<16>(bm)); bm = red32_max(bm);
        cbase = -(P.ref_diff + bm);
    } else {
        cbase = P.cum[(size_t)bh * SEQ + qw0 + r32] - P.ref_fox;
    }
    bf16x8 qr[4];
#pragma unroll
    for (int d0 = 0; d0 < 4; ++d0) qr[d0] = *(const bf16x8*)(P.Q + (rowbase + qw0 + r32) * DM + colqk + mp * 64 + d0 * 16 + hi * 8);

    auto issue = [&](int t, int st) {
        LAS unsigned char* sb = lds + st * AT_STAGE;
        const bf16_t* kp = P.K + (rowbase + 64 * t + lane) * DM + colqk + wid * 8;
#pragma unroll
        for (int m = 0; m < NMAP; ++m) glds16(kp + m * 64, sb + m * 8192 + wid * 1024);
#pragma unroll
        for (int q = 0; q < NMAP; ++q) { const int pp = wid + 8 * q, dblk = pp >> 2, kvb = pp & 3;
            glds16(P.V + (rowbase + 64 * t + 16 * kvb + (lane >> 2)) * DM + colqk + dblk * 32 + (lane & 3) * 8, sb + 16384 + pp * 1024); }
    };

    f32x16 o[ND], ol = f32x16{}; float lsum = 0.f;
#pragma unroll
    for (int d = 0; d < ND; ++d) o[d] = f32x16{};
    const bf16x8 ones = (bf16x8){0x3f80, 0x3f80, 0x3f80, 0x3f80, 0x3f80, 0x3f80, 0x3f80, 0x3f80};

    issue(0, 0);
    const float* cumrow = P.cum + (size_t)bh * SEQ + lane;
    float ckn = 0.f;
    if (NMAP == 1 && wid == 0) ((LAS float*)(lds + AT_CK))[lane] = cumrow[0];
    for (int t = 0; t < NT; ++t) {
        const int st = t & 1;
        asm volatile("s_waitcnt vmcnt(0)" ::: "memory");
        __syncthreads();
        if (t + 1 < NT) { issue(t + 1, st ^ 1); if (NMAP == 1 && wid == 0) ckn = cumrow[64 * (t + 1)]; }
        if (t <= tl) {
            const LAS char* sb = (const LAS char*)(lds + st * AT_STAGE);
            f32x16 p[2];
            if (NMAP == 1) {
                const LAS float* ck = (const LAS float*)(lds + AT_CK + st * 256);
                const f32x4 c0 = *(const LAS f32x4*)(ck + 4 * hi), c1 = *(const LAS f32x4*)(ck + 4 * hi + 8), c2 = *(const LAS f32x4*)(ck + 4 * hi + 16), c3 = *(const LAS f32x4*)(ck + 4 * hi + 24);
                const f32x4 c4 = *(const LAS f32x4*)(ck + 4 * hi + 32), c5 = *(const LAS f32x4*)(ck + 4 * hi + 40), c6 = *(const LAS f32x4*)(ck + 4 * hi + 48), c7 = *(const LAS f32x4*)(ck + 4 * hi + 56);
                const f32x16 k0 = (f32x16){c0[0], c0[1], c0[2], c0[3], c1[0], c1[1], c1[2], c1[3], c2[0], c2[1], c2[2], c2[3], c3[0], c3[1], c3[2], c3[3]};
                const f32x16 k1 = (f32x16){c4[0], c4[1], c4[2], c4[3], c5[0], c5[1], c5[2], c5[3], c6[0], c6[1], c6[2], c6[3], c7[0], c7[1], c7[2], c7[3]};
                p[0] = cbase - k0; p[1] = cbase - k1;
            } else {
#pragma unroll
                for (int r = 0; r < 16; ++r) { p[0][r] = cbase; p[1][r] = cbase; }
            }
            { const LAS char* kb = sb + mp * 8192 + hi * 1024 + r32 * 16;
#pragma unroll
              for (int d0 = 0; d0 < 4; ++d0) { const bf16x8 b0 = *(const LAS bf16x8*)(kb + d0 * 2048), b1 = *(const LAS bf16x8*)(kb + d0 * 2048 + 512);
                  p[0] = __builtin_amdgcn_mfma_f32_32x32x16_bf16(b0, qr[d0], p[0], 0, 0, 0); p[1] = __builtin_amdgcn_mfma_f32_32x32x16_bf16(b1, qr[d0], p[1], 0, 0, 0); } }
            const int qd = qw0 + r32 - 64 * t - 4 * hi;
            if (NMAP == 2 && (64 * t + 63 + 113 > qw0)) {
                asm volatile("" ::: "memory");
#pragma unroll
                for (int j = 0; j < 8; ++j)
#pragma unroll
                    for (int i = 0; i < 4; ++i) { int n = qd - 8 * j - i; n = n < 0 ? 0 : (n > 127 ? 127 : n); p[j >> 2][4 * (j & 3) + i] += tb[n]; }
            }
            if (64 * t + 63 > qw0) {
                asm volatile("" ::: "memory");
#pragma unroll
                for (int j = 0; j < 8; ++j)
#pragma unroll
                    for (int i = 0; i < 4; ++i) if (8 * j + i > qd) p[j >> 2][4 * (j & 3) + i] = -INFINITY;
            }
#pragma unroll
            for (int r = 0; r < 16; ++r) { p[0][r] = fast_exp2(p[0][r]); p[1][r] = fast_exp2(p[1][r]); }
            if (NMAP == 2) { const f32x16 sv = p[0] + p[1];
                lsum += ((sv[0] + sv[1]) + (sv[2] + sv[3])) + ((sv[4] + sv[5]) + (sv[6] + sv[7])) + ((sv[8] + sv[9]) + (sv[10] + sv[11])) + ((sv[12] + sv[13]) + (sv[14] + sv[15])); }
            bf16x8 pw[4];
#pragma unroll
            for (int ks = 0; ks < 4; ++ks) { const int hp = ks >> 1, bs = 8 * (ks & 1);
                u32x4 w; w.x = cvt_pk_bf16(p[hp][bs + 0], p[hp][bs + 1]); w.y = cvt_pk_bf16(p[hp][bs + 2], p[hp][bs + 3]); w.z = cvt_pk_bf16(p[hp][bs + 4], p[hp][bs + 5]); w.w = cvt_pk_bf16(p[hp][bs + 6], p[hp][bs + 7]);
                pw[ks] = __builtin_bit_cast(bf16x8, w); }
            const LAS char* vp = sb + 16384 + ((lane >> 4) & 1) * 32 + (lane & 3) * 8 + (4 * hi + ((lane & 15) >> 2)) * 64;
            if (NMAP == 1) {
#pragma unroll
                for (int ks = 0; ks < 4; ++ks) ol = __builtin_amdgcn_mfma_f32_32x32x16_bf16(pw[ks], ones, ol, 0, 0, 0);
            }
#pragma unroll
            for (int d = 0; d < ND; ++d)
#pragma unroll
                for (int ks = 0; ks < 4; ++ks) { const s16x4 lo = vtr(vp + d * 4096 + ks * 1024), hh = vtr(vp + d * 4096 + ks * 1024 + 512);
                    const bf16x8 vf = (bf16x8){lo[0], lo[1], lo[2], lo[3], hh[0], hh[1], hh[2], hh[3]};
                    o[d] = __builtin_amdgcn_mfma_f32_32x32x16_bf16(pw[ks], vf, o[d], 0, 0, 0); }
        }
        if (NMAP == 1 && wid == 0 && t + 1 < NT) ((LAS float*)(lds + AT_CK + (st ^ 1) * 256))[lane] = ckn;
    }
    float inv[16];
    if (NMAP == 1) {
#pragma unroll
        for (int r = 0; r < 16; ++r) inv[r] = fast_rcp(ol[r]);
    } else {
        LAS float* wsf = (LAS float*)(lds + AT_WSF) + wid * 32;
        const float lt = red32_add(lsum);
        asm volatile("s_waitcnt lgkmcnt(0)" ::: "memory");
        if (hi == 0) wsf[r32] = fast_rcp(lt);
        asm volatile("s_waitcnt lgkmcnt(0)" ::: "memory");
#pragma unroll
        for (int r = 0; r < 16; ++r) inv[r] = wsf[crow(r, hi)];
        asm volatile("s_waitcnt lgkmcnt(0)" ::: "memory");
    }
    if (NMAP == 1) {
        bf16_t* Ow = P.O + (rowbase + qw0) * DM + 512 + h * 64 + r32;
#pragma unroll
        for (int r = 0; r < 16; ++r)
#pragma unroll
            for (int d = 0; d < ND; ++d) Ow[(size_t)crow(r, hi) * DM + d * 32] = (bf16_t)(cvt_pk_bf16(o[d][r] * inv[r], 0.f) & 0xffffu);
        __syncthreads();
    } else {
        __syncthreads();
        LAS float* xb = (LAS float*)lds + (size_t)rb * (ND * 16 * 64) + lane;
        if (mp == 1) {
#pragma unroll
            for (int d = 0; d < ND; ++d)
#pragma unroll
                for (int r = 0; r < 16; ++r) xb[(d * 16 + r) * 64] = o[d][r] * inv[r];
        }
        __syncthreads();
        if (mp == 0) {
            float ss[16];
#pragma unroll
            for (int r = 0; r < 16; ++r) {
                float s = 0.f;
#pragma unroll
                for (int d = 0; d < ND; ++d) { const float v = o[d][r] * inv[r] - P.lam * xb[(d * 16 + r) * 64]; o[d][r] = v; s += v * v; }
                s += swz_xor<1>(s); s += swz_xor<2>(s); s += swz_xor<4>(s); s += swz_xor<8>(s); s += swz_xor<16>(s);
                ss[r] = rsqrtf(s * (1.0f / 128.0f) + EPS) * (1.0f - P.lam_init);
            }
            bf16_t* Ow = P.O + (rowbase + qw0) * DM + h * 128 + r32;
#pragma unroll
            for (int d = 0; d < ND; ++d) { const float gd = P.subg[d * 32 + r32];
#pragma unroll
                for (int r = 0; r < 16; ++r) Ow[(size_t)crow(r, hi) * DM + d * 32] = (bf16_t)(cvt_pk_bf16(o[d][r] * ss[r] * gd, 0.f) & 0xffffu); }
        }
        __syncthreads();
    }
}

__device__ void attn_phase(ArgsP a, int j, LAS unsigned char* lds) {
    const int tid = opaque_tid(), lane = tid & 63;
    AttnP P;
    P.Q = (const bf16_t*)(a->ws + WS_R + R_Q); P.K = (const bf16_t*)(a->ws + WS_R + R_K); P.V = (const bf16_t*)(a->ws + WS_R + R_V); P.O = (bf16_t*)(a->ws + WS_R + R_Q);
    P.cum = (const float*)(a->ws + WS_CUM); P.relb = a->in[22]; P.subg = a->in[19] + j * 128;
    const float d1 = wave_sum(a->in[15][j * 64 + lane] * a->in[16][j * 64 + lane]), d2 = wave_sum(a->in[17][j * 64 + lane] * a->in[18][j * 64 + lane]);
    {
        float gdq = fabsf(a->in[13][j * 64 + lane]), gdk = fabsf(a->in[14][j * 64 + lane]), gfq = fabsf(a->in[20][j * 64 + lane]), gfk = fabsf(a->in[21][j * 64 + lane]);
#define WMAX(v) v = fmaxf(v, swz_xor<1>(v)); v = fmaxf(v, swz_xor<2>(v)); v = fmaxf(v, swz_xor<4>(v)); v = fmaxf(v, swz_xor<8>(v)); v = fmaxf(v, swz_xor<16>(v)); v = red32_max(v)
        WMAX(gdq); WMAX(gdk); WMAX(gfq); WMAX(gfk);
#undef WMAX
        P.ref_diff = __int_as_float(__builtin_amdgcn_readfirstlane(__float_as_int(64.0f * QSCALE * 1.02f * gdq * gdk)));
        P.ref_fox = __int_as_float(__builtin_amdgcn_readfirstlane(__float_as_int(64.0f * QSCALE * 1.02f * gfq * gfk)));
    }
    const int jo = opaque_s(j);
    const float li_ = (jo == 0) ? 0.2f : 0.47071301821013583f;
    P.lam_init = li_;
    P.lam = __int_as_float(__builtin_amdgcn_readfirstlane(__float_as_int(expf(d1) - expf(d2) + li_)));
    unsigned* ctr = (unsigned*)(a->ws + WS_CTL) + 64 * (1 + j);
    LAS unsigned* misc = (LAS unsigned*)(lds + AT_MISC);
    for (;;) {
        if (tid == 0) misc[0] = atomicAdd(ctr, 1u);
        __syncthreads();
        const int idx = (int)misc[0];
        __syncthreads();
        if (idx >= 2048) break;
        int type, bh, L;
        if (idx < 512) { L = 32 - (idx >> 5); type = 1; bh = idx & 31; }
        else { const int jj = idx - 512; L = 16 - jj / 96; const int r = jj % 96; if (r < 32) { type = 1; bh = r; } else { type = 0; bh = r - 32; } }
        if (type == 0) attn_unit<1>(lds, P, bh >> 3, bh & 7, L - 1);
        else attn_unit<2>(lds, P, bh >> 2, bh & 3, L - 1);
    }
}

#define XB_XCNT(j)  (256  + 64 * (j))
#define XB_XSUB(j)  (1280 + 64 * (j))
#define XB_XGEN(j)  (2304 + 64 * (j))
#define XB_TOP      3328
#define XB_TOPGEN   3392
constexpr int CW_BAR = 4096;
constexpr int LDS_BARST = 131072 + 12288 + 1024 + 256;
__device__ __forceinline__ unsigned xb_ld(unsigned* p)              { return __hip_atomic_load(p, __ATOMIC_RELAXED, __HIP_MEMORY_SCOPE_AGENT); }
__device__ __forceinline__ unsigned xb_add(unsigned* p, unsigned v) { return __hip_atomic_fetch_add(p, v, __ATOMIC_RELAXED, __HIP_MEMORY_SCOPE_AGENT); }
__device__ __forceinline__ unsigned xb_xcc_id() { return (unsigned)__builtin_amdgcn_s_getreg((3 << 11) | 20) & 0xFu; }
#define XB_SPIN(cond) do { unsigned _sp = 0; while (cond) { __builtin_amdgcn_s_sleep(1); if (++_sp > (1u << 24)) break; } } while (0)
__device__ __forceinline__ void grid_barrier(unsigned* ctl, unsigned G) {
    unsigned* bar = ctl + CW_BAR;
    const int tid = opaque_tid();
    asm volatile("s_waitcnt vmcnt(0) lgkmcnt(0)" ::: "memory");
    __syncthreads();
    if (tid == 0) {
        volatile LAS unsigned* st = (volatile LAS unsigned*)((LAS unsigned char*)lds_raw + LDS_BARST);
        const unsigned x = xb_xcc_id();
        unsigned nloc = st[0], nx = st[1];
        if (nloc == 0u) {
            unsigned sum, cnt, mine, sp = 0u;
            for (;;) {
                sum = 0u; cnt = 0u; mine = 0u;
#pragma unroll
                for (unsigned j = 0; j < 16; ++j) { const unsigned c = xb_ld(&bar[XB_XCNT(j)]); sum += c; cnt += (c > 0u) ? 1u : 0u; mine = (j == x) ? c : mine; }
                if (sum == G) break;
                __builtin_amdgcn_s_sleep(1);
                if (++sp > (1u << 22)) break;
            }
            nloc = mine > 0u ? mine : 1u; nx = cnt > 0u ? cnt : 1u; st[0] = nloc; st[1] = nx;
        }
        const unsigned old = xb_add(&bar[XB_XSUB(x)], 1u);
        const unsigned gen = old / nloc;
        if (old + 1u == (gen + 1u) * nloc) {
            __builtin_amdgcn_fence(__ATOMIC_RELEASE, "agent");
            asm volatile("s_waitcnt vmcnt(0)" ::: "memory");
            const unsigned og = xb_add(&bar[XB_TOP], 1u);
            const unsigned tg = og / nx;
            if (og + 1u == (tg + 1u) * nx) xb_add(&bar[XB_TOPGEN], 1u);
            else XB_SPIN(xb_ld(&bar[XB_TOPGEN]) == tg);
            __builtin_amdgcn_fence(__ATOMIC_ACQUIRE, "agent");
            xb_add(&bar[XB_XGEN(x)], 1u);
            asm volatile("s_waitcnt vmcnt(0)" ::: "memory");
        } else {
            XB_SPIN(xb_ld(&bar[XB_XGEN(x)]) == gen);
            __builtin_amdgcn_fence(__ATOMIC_ACQUIRE, "agent");
            asm volatile("s_waitcnt vmcnt(0)" ::: "memory");
        }
    }
    __syncthreads();
}

__global__ void __launch_bounds__(512, 2) fwd_megakernel(Args a_unused) {
    LAS unsigned char* lds = (LAS unsigned char*)lds_raw;
    cg::grid_group grid = cg::this_grid();
    const int G0 = gridDim.x, bx0 = blockIdx.x;
#define G opaque_s(G0)
#define bx opaque_s(bx0)
    LAS float* rs = (LAS float*)(lds + LDS_RS);
    { const int t0 = threadIdx.x; const int key = hw_wave_key(); if ((t0 & 63) == 0) *(volatile LAS int*)(lds + LDS_WIDTAB + key * 4) = t0 >> 6; }
    if (threadIdx.x == 0) { volatile LAS unsigned* st = (volatile LAS unsigned*)(lds + LDS_BARST); st[0] = 0u; st[1] = 0u;
        (void)xb_add((unsigned*)(kargs()->ws + WS_CTL) + CW_BAR + XB_XCNT(xb_xcc_id()), 1u); }
    grid.sync();
#define GRID_SYNC() grid_barrier((unsigned*)(kargs()->ws + WS_CTL), (unsigned)G)

    {
        ArgsP a = kargs();
        const int tid = opaque_tid(), lane = tid & 63, wid = tid >> 6, Gp = G, bxp = bx;
        LAS float* scr = (LAS float*)(lds + wid * 16384);
        const int gw = bxp * 8 + wid, NGW = Gp * 8;
        for (int it = gw; it < N_CONVERT_ITEMS; it += NGW) convert_item(a, it, scr, lane);
        bf16_t* XB = (bf16_t*)(a->ws + WS_XB); float* SS = (float*)(a->ws + WS_SS); const float* xin = a->in[0];
        for (int m = gw; m < MTOK; m += NGW) {
            const f32x4* xr = (const f32x4*)(xin + (size_t)m * DM) + lane;
            u32x2* ob = (u32x2*)(XB + (size_t)m * DM) + lane;
            float s = 0.f;
#pragma unroll
            for (int jx = 0; jx < 4; ++jx) { const f32x4 v = xr[64 * jx]; s += (v[0] * v[0] + v[1] * v[1]) + (v[2] * v[2] + v[3] * v[3]);
                u32x2 w; w.x = cvt_pk_bf16(v[0], v[1]); w.y = cvt_pk_bf16(v[2], v[3]); ob[64 * jx] = w; }
            s = wave_sum(s);
            if (lane < 32) SS[(size_t)m * 32 + lane] = lane == 0 ? s : 0.f;
        }
    }
    GRID_SYNC();

#pragma unroll 1
    for (int layer = 0; layer < 4; ++layer) {
        const int j = layer >> 1;
#pragma unroll 1
        for (int f = 0; f < 2; ++f) {
            if (f == 1) {
                if ((layer & 1) == 0) {
                    {
                        ArgsP a = kargs(); unsigned char* ws = a->ws;
                        {
                            const int t = opaque_tid();
                            if (t < 256) { const int sel = t >> 6, d = t & 63; const float* gp = a->in[sel == 0 ? 13 : (sel == 1 ? 14 : (sel == 2 ? 20 : 21))]; ((LAS float*)(lds + LDS_GT))[t] = gp[j * 64 + d]; }
                        }
                        pg8::Gemm g{(const bf16_t*)(ws + WS_XB), (const bf16_t*)(ws + WS_WIN + (size_t)j * WIN_SZ), DM, DM, DM};
                        pg8::StaticOrder S; S.init(MTOK, 3328, G, bx);
                        compute_rowscale(S, (const float*)(ws + WS_SS), rs);
                        pg8::EpiInProj E{(bf16_t*)(ws + WS_R + R_Q), (float*)(ws + WS_LF), rs, (const LAS float*)(lds + LDS_GT), a->in[12] + j * 8};
                        pg8::gemm_phase(lds, g, S, E);
                    }
                    GRID_SYNC();
                    {
                        ArgsP a = kargs();
                        const int bxp = bx;
                        if (bxp < 64) cumsum_bh(a, bxp, lds);
                        else s5_setup(a, j, (bxp - 64) / 3, (bxp - 64) % 3, lds);
                    }
                    GRID_SYNC();
                    attn_phase(kargs(), j, lds);
                    GRID_SYNC();
                    {
                        ArgsP a = kargs(); unsigned char* ws = a->ws;
                        pg8::Gemm g{(const bf16_t*)(ws + WS_R + R_Q), (const bf16_t*)(ws + WS_WOUT + (size_t)j * WOUT_SZ), DM, DM, DM};
                        pg8::StaticOrder S; S.init(MTOK, DM, G, bx);
                        pg8::EpiResAdd E{nullptr, (bf16_t*)(ws + WS_XB), (float*)(ws + WS_SS), 1.0f};
                        pg8::gemm_phase(lds, g, S, E);
                    }
                    GRID_SYNC();
                } else {
                    s5_build_u(kargs(), layer, lds);
                    GRID_SYNC();
                    {
                        ArgsP a = kargs(); unsigned char* ws = a->ws;
                        pg8::Gemm g{(const bf16_t*)(ws + WS_R + R_UA), (const bf16_t*)(ws + WS_S5W1), 640, 512, 512};
                        pg8::S5StateOrder S{G, bx};
                        pg8::EpiS5State E{(float*)(ws + WS_R + R_SST)};
                        pg8::gemm_phase(lds, g, S, E);
                    }
                    GRID_SYNC();
                    s5_scan(kargs(), j);
                    GRID_SYNC();
                    {
                        ArgsP a = kargs(); unsigned char* ws = a->ws;
                        pg8::Gemm g{(const bf16_t*)(ws + WS_R + R_UA), (const bf16_t*)(ws + WS_S5WA), 640, 640, 640};
                        pg8::S5OutOrder S{G, bx};
                        pg8::EpiS5Out E{(const bf16_t*)(ws + WS_R + R_UA), a->in[30] + j * DM, (bf16_t*)(ws + WS_R + R_Y)};
                        pg8::gemm_phase(lds, g, S, E);
                    }
                    GRID_SYNC();
                    {
                        ArgsP a = kargs(); unsigned char* ws = a->ws;
                        pg8::Gemm g{(const bf16_t*)(ws + WS_R + R_Y), (const bf16_t*)(ws + WS_WGLU + (size_t)j * WGLU_SZ), DM, DM, DM};
                        pg8::StaticOrder S; S.init(MTOK, 2048, G, bx);
                        pg8::EpiGlu E{(bf16_t*)(ws + WS_XB), (float*)(ws + WS_SS)};
                        pg8::gemm_phase(lds, g, S, E);
                    }
                    GRID_SYNC();
                }
            }
            const int mi = layer * 2 + f;
            {
                ArgsP a = kargs(); unsigned char* ws = a->ws;
                pg8::Gemm g{(const bf16_t*)(ws + WS_XB), (const bf16_t*)(ws + WS_WGU + (size_t)mi * WGU_SZ), DM, DM, DM};
                pg8::StaticOrder S; S.init(MTOK, 5632, G, bx);
                compute_rowscale(S, (const float*)(ws + WS_SS), rs);
                pg8::EpiGateUp E{(bf16_t*)(ws + WS_R + R_H), rs};
                pg8::gemm_phase(lds, g, S, E);
            }
            GRID_SYNC();
            {
                ArgsP a = kargs(); unsigned char* ws = a->ws;
                pg8::Gemm g{(const bf16_t*)(ws + WS_R + R_H), (const bf16_t*)(ws + WS_WDN + (size_t)mi * WDN_SZ), FF, FF, FF};
                pg8::StaticOrder S; S.init(MTOK, DM, G, bx);
                pg8::EpiResAdd E{(mi == 7) ? a->out : nullptr, (bf16_t*)(ws + WS_XB), (float*)(ws + WS_SS), 0.5f};
                pg8::gemm_phase(lds, g, S, E);
            }
            GRID_SYNC();
        }
    }
}
#undef G
#undef bx
#undef GRID_SYNC

extern "C" void kernel_launch(void* const* d_in, const int* in_sizes, int n_in, void* d_out, int out_size, void* d_ws, size_t ws_size, hipStream_t stream) {
    static int grid = 0;
    if (grid == 0) {
        if (n_in != 33 || out_size != MTOK * DM || ws_size < WS_END) { fprintf(stderr, "kernel_launch: unexpected shapes (n_in %d out %d ws %zu, need ws >= %zu)\n", n_in, out_size, ws_size, (size_t)WS_END); grid = -1; return; }
        int dev = 0, cus = 0, per_cu = 0;
        hipGetDevice(&dev); hipDeviceGetAttribute(&cus, hipDeviceAttributeMultiprocessorCount, dev);
        hipFuncSetAttribute((const void*)fwd_megakernel, hipFuncAttributeMaxDynamicSharedMemorySize, LDS_BYTES);
        hipOccupancyMaxActiveBlocksPerMultiprocessor(&per_cu, (const void*)fwd_megakernel, 512, LDS_BYTES);
        (void)hipGetLastError();
        if (per_cu < 1) { fprintf(stderr, "kernel_launch: occupancy query says %d blocks/CU\n", per_cu); per_cu = 1; }
        grid = cus;
        if (grid != 256) fprintf(stderr, "kernel_launch: warning: %d CUs (built for 256)\n", grid);
    }
    if (grid < 0) return;
    hipMemsetAsync((char*)d_ws + WS_CTL, 0, 65536, stream);
    Args a{};
    for (int i = 0; i < 33; ++i) a.in[i] = (const float*)d_in[i];
    a.out = (float*)d_out; a.ws = (unsigned char*)d_ws;
    void* args[] = {&a};
    hipError_t e = hipLaunchCooperativeKernel((const void*)fwd_megakernel, dim3(grid), dim3(512), args, LDS_BYTES, stream);
    if (e != hipSuccess) fprintf(stderr, "cooperative launch failed: %s (grid %d)\n", hipGetErrorString(e), grid);
}
```
